# Optimizing an MI355X kernel written in HIP

```python
import jax, jax.numpy as jnp
from jax import lax
import numpy as np

D_MODEL = 1024
BATCH = 32
SEQ = 256
DEPTH = 4
DEC_BATCH = 4
DEC_SEQ = 2048
PAST_LEN = 512

GRID_W = 64
HEAD_DIM = 64
N_MOD = 6
EPS = 1e-6
ROPE_BASE = 10000.0
NEG = -1e30
MLA_HEADS = 12
Q_LORA = 384
KV_LORA = 256
QK_NOPE = 64
QK_ROPE = 32
V_DIM = 64
MLA_SCALE = (QK_NOPE + QK_ROPE) ** -0.5
MLA_QBLOCK = 128
POOL_WINDOWS = (2, 4, 8, 16)
POOL_GROUP = D_MODEL // 16
POOL_DIM = 4 * POOL_GROUP
NA_HEADS = 8
NA_KH_MAX = 8
NA_KW = 16
NA_QCB = 16
NA_KCB = 32
SWA_HEADS = 8
SWA_KV_HEADS = 2
SWA_GROUP = SWA_HEADS // SWA_KV_HEADS
SWA_WINDOW = 128
SWA_BLOCK = 128
D_FF = 2816
CONV_W = 3
EVEN_IN = Q_LORA + KV_LORA + QK_ROPE + POOL_DIM
ODD_IN = 3 * NA_HEADS * HEAD_DIM + (SWA_HEADS + 2 * SWA_KV_HEADS) * HEAD_DIM
MIX_WIDTH = MLA_HEADS * V_DIM + POOL_DIM
N_EVEN = (DEPTH + 1) // 2
N_ODD = DEPTH // 2

kernel_name = 'hybrid_diffusion_trunk_step'


def rmsnorm(x, g):
    xf = x.astype(jnp.float32)
    y = xf * lax.rsqrt(jnp.mean(xf * xf, axis=-1, keepdims=True) + EPS)
    return (y * g.astype(jnp.float32)).astype(x.dtype)


def adaln(cvec, w_mod, b_mod):
    m = jax.nn.silu(cvec) @ w_mod + b_mod
    return m.reshape(cvec.shape[0], N_MOD, D_MODEL)[:, :, None, :]


def modulate(h, shift, scale):
    return h * (1 + scale) + shift


def rope_2d(x):
    n, r = x.shape[1], x.shape[-1]
    half = r // 2
    nf = half // 2
    t = jnp.arange(n)
    freqs = ROPE_BASE ** (-jnp.arange(nf, dtype=jnp.float32) / nf)

    def rot(xp, pos):
        ang = pos.astype(jnp.float32)[:, None] * freqs
        cos, sin = jnp.cos(ang)[:, None, :], jnp.sin(ang)[:, None, :]
        x1, x2 = xp[..., :nf], xp[..., nf:]
        return jnp.concatenate([x1 * cos - x2 * sin, x1 * sin + x2 * cos], axis=-1)

    out = jnp.concatenate([rot(x[..., :half], t // GRID_W), rot(x[..., half:], t % GRID_W)], axis=-1)
    return out.astype(x.dtype)


def attend(q, k, v, sink=None):
    d = q.shape[-1]
    s = jnp.einsum('bqhgd,bkhd->bhgqk', q, k).astype(jnp.float32) * (d ** -0.5)
    if sink is not None:
        sk = sink.reshape(1, SWA_KV_HEADS, SWA_GROUP, 1, 1).astype(jnp.float32)
        s = jnp.concatenate([s, jnp.broadcast_to(sk, s.shape[:-1] + (1,))], axis=-1)
    p = jax.nn.softmax(s, axis=-1)
    if sink is not None:
        p = p[..., :-1]
    return jnp.einsum('bhgqk,bkhd->bqhgd', p.astype(v.dtype), v)


def multiscale_pool(xp, w_pool, pool_scale):
    b, n, _ = xp.shape
    xf = xp.astype(jnp.float32)
    cs = jnp.concatenate([jnp.zeros_like(xf[:, :1]), jnp.cumsum(xf, axis=1)], axis=1)
    t = np.arange(n)
    outs = []
    for g, w in enumerate(POOL_WINDOWS):
        lo = np.clip(t - w // 2, 0, n)
        hi = np.clip(t + w // 2, 0, n)
        sl = slice(g * POOL_GROUP, (g + 1) * POOL_GROUP)
        seg = cs[:, :, sl]
        cnt = jnp.asarray((hi - lo).astype(np.float32))[None, :, None]
        outs.append((seg[:, hi] - seg[:, lo]) / cnt - xf[:, :, sl])
    p = jnp.stack(outs, axis=2)
    y = jnp.einsum('bngc,gcd->bngd', p, w_pool.astype(jnp.float32)).reshape(b, n, POOL_DIM)
    return (y * pool_scale.astype(jnp.float32)).astype(xp.dtype)


def mla_split(z):
    a = Q_LORA
    b_ = a + KV_LORA
    c_ = b_ + QK_ROPE
    return z[..., :a], z[..., a:b_], z[..., b_:c_], z[..., c_:]


def mla_queries(qa, g_q, w_uq, positional):
    b, n, _ = qa.shape
    q = (rmsnorm(qa, g_q) @ w_uq).reshape(b, n, MLA_HEADS, QK_NOPE + QK_ROPE)
    q_nope, q_rope = q[..., :QK_NOPE], q[..., QK_NOPE:]
    if positional:
        q_rope = rope_2d(q_rope)
    return q_nope, q_rope


def mla_expand(latent, w_ukv):
    b, n, _ = latent.shape
    kv = (latent[..., :KV_LORA] @ w_ukv).reshape(b, n, MLA_HEADS, QK_NOPE + V_DIM)
    return kv[..., :QK_NOPE], latent[..., KV_LORA:], kv[..., QK_NOPE:]


def mla_attend(q_nope, q_rope, k_nope, k_rope, v):
    s = (jnp.einsum('bqhd,bkhd->bhqk', q_nope, k_nope)
         + jnp.einsum('bqhr,bkr->bhqk', q_rope, k_rope)).astype(jnp.float32) * MLA_SCALE
    p = jax.nn.softmax(s, axis=-1).astype(v.dtype)
    return jnp.einsum('bhqk,bkhd->bqhd', p, v)


def even_context(h, w_in, g_q, g_kv, w_uq, w_ukv, w_pool, pool_scale, w_out):
    b, n, _ = h.shape
    qa, ckv, kr, xp = mla_split(h @ w_in)
    latent = jnp.concatenate([rmsnorm(ckv, g_kv), kr], axis=-1)
    q_nope, q_rope = mla_queries(qa, g_q, w_uq, False)
    k_nope, k_rope, v = mla_expand(latent, w_ukv)
    o = mla_attend(q_nope, q_rope, k_nope, k_rope, v).reshape(b, n, MLA_HEADS * V_DIM)
    y_pool = multiscale_pool(xp, w_pool, pool_scale)
    return jnp.concatenate([o, y_pool], axis=-1) @ w_out, latent


def even_latent(h, lat_ctx, w_in, g_q, g_kv, w_uq, w_ukv, w_pool, pool_scale, w_out):
    b, n, _ = h.shape
    qa, ckv, kr, xp = mla_split(h @ w_in)
    kr = rope_2d(kr[:, :, None, :])[:, :, 0, :]
    lat = jnp.concatenate([rmsnorm(ckv, g_kv), kr], axis=-1)
    q_nope, q_rope = mla_queries(qa, g_q, w_uq, True)
    k_nope, k_rope, v = mla_expand(jnp.concatenate([lat, lat_ctx.astype(lat.dtype)], axis=1), w_ukv)
    nb = n // MLA_QBLOCK
    qn_b = q_nope.reshape(b, nb, MLA_QBLOCK, MLA_HEADS, QK_NOPE).swapaxes(0, 1)
    qr_b = q_rope.reshape(b, nb, MLA_QBLOCK, MLA_HEADS, QK_ROPE).swapaxes(0, 1)
    o = lax.map(lambda qs: mla_attend(qs[0], qs[1], k_nope, k_rope, v), (qn_b, qr_b))
    o = o.swapaxes(0, 1).reshape(b, n, MLA_HEADS * V_DIM)
    y_pool = multiscale_pool(xp, w_pool, pool_scale)
    return jnp.concatenate([o, y_pool], axis=-1) @ w_out


def odd_split(z):
    b, n, _ = z.shape
    dna = NA_HEADS * HEAD_DIM
    dsq = SWA_HEADS * HEAD_DIM
    dkv = SWA_KV_HEADS * HEAD_DIM
    offs = [int(o) for o in np.cumsum([0, dna, dna, dna, dsq, dkv, dkv])]
    parts = [z[..., offs[i]:offs[i + 1]] for i in range(6)]
    q_na = parts[0].reshape(b, n, NA_HEADS, HEAD_DIM)
    k_na = parts[1].reshape(b, n, NA_HEADS, HEAD_DIM)
    v_na = parts[2].reshape(b, n, NA_HEADS, HEAD_DIM)
    q_sw = parts[3].reshape(b, n, SWA_KV_HEADS, SWA_GROUP, HEAD_DIM)
    k_sw = parts[4].reshape(b, n, SWA_KV_HEADS, HEAD_DIM)
    v_sw = parts[5].reshape(b, n, SWA_KV_HEADS, HEAD_DIM)
    return q_na, k_na, v_na, q_sw, k_sw, v_sw


def na_latent(q, k, v, k_ctx, v_ctx, rpb):
    b, n, hh, d = q.shape
    rows = n // GRID_W
    kh = min(NA_KH_MAX, rows)
    ncb = GRID_W // NA_QCB
    row_start = np.clip(np.arange(rows) - kh // 2, 0, rows - kh)
    dr_idx = row_start[:, None] + np.arange(kh)[None, :] - np.arange(rows)[:, None] + NA_KH_MAX - 1
    qcol = np.arange(GRID_W).reshape(ncb, NA_QCB)
    kcol_start = np.clip(np.arange(ncb) * NA_QCB - (NA_KCB - NA_QCB) // 2, 0, GRID_W - NA_KCB)
    kcol = kcol_start[:, None] + np.arange(NA_KCB)[None, :]
    qcol_start = np.clip(qcol - NA_KW // 2, 0, GRID_W - NA_KW)
    col_mask = (kcol[:, None, :] >= qcol_start[..., None]) & (kcol[:, None, :] < qcol_start[..., None] + NA_KW)
    dc_idx = np.clip(kcol[:, None, :] - qcol[..., None] + NA_KW - 1, 0, 2 * NA_KW - 2)
    kg = k.reshape(b, rows, GRID_W, hh, d)
    vg = v.reshape(b, rows, GRID_W, hh, d)
    qg = q.reshape(b, rows, ncb, NA_QCB, hh, d).swapaxes(0, 1)
    scale = d ** -0.5
    nloc = kh * NA_KCB
    mask = jnp.asarray(col_mask)[:, :, None, :]

    def row_block(args):
        q_r, r0, dr = args
        k_r = lax.dynamic_slice_in_dim(kg, r0, kh, axis=1)[:, :, kcol]
        v_r = lax.dynamic_slice_in_dim(vg, r0, kh, axis=1)[:, :, kcol]
        s_loc = jnp.einsum('bcqhd,bkcjhd->bhcqkj', q_r, k_r).astype(jnp.float32) * scale
        bias = rpb[:, dr[None, None, :, None], dc_idx[:, :, None, :]].astype(jnp.float32)
        s_loc = jnp.where(mask, s_loc + bias, NEG)
        s_ctx = jnp.einsum('bcqhd,blhd->bhcql', q_r, k_ctx).astype(jnp.float32) * scale
        s = jnp.concatenate([s_loc.reshape(b, hh, ncb, NA_QCB, nloc), s_ctx], axis=-1)
        p = jax.nn.softmax(s, axis=-1).astype(v.dtype)
        p_loc = p[..., :nloc].reshape(b, hh, ncb, NA_QCB, kh, NA_KCB)
        return (jnp.einsum('bhcqkj,bkcjhd->bcqhd', p_loc, v_r)
                + jnp.einsum('bhcql,blhd->bcqhd', p[..., nloc:], v_ctx))

    o = lax.map(row_block, (qg, jnp.asarray(row_start, jnp.int32), jnp.asarray(dr_idx, jnp.int32)))
    return o.swapaxes(0, 1).reshape(b, n, hh * d)


def swa_latent(q, k, v, k_ctx, v_ctx, sink):
    b, n, hk, g, d = q.shape
    nb = n // SWA_BLOCK
    span = SWA_BLOCK + 2 * SWA_WINDOW
    scale = d ** -0.5
    qb = q.reshape(b, nb, SWA_BLOCK, hk, g, d)
    padw = ((0, 0), (SWA_WINDOW, SWA_WINDOW), (0, 0), (0, 0))
    idx = np.arange(nb)[:, None] * SWA_BLOCK + np.arange(span)[None, :]
    kb = jnp.pad(k, padw)[:, idx]
    vb = jnp.pad(v, padw)[:, idx]
    tq = np.arange(nb)[:, None, None] * SWA_BLOCK + np.arange(SWA_BLOCK)[None, :, None]
    sk = np.arange(nb)[:, None, None] * SWA_BLOCK - SWA_WINDOW + np.arange(span)[None, None, :]
    band = (sk >= 0) & (sk < n) & (np.abs(tq - sk) <= SWA_WINDOW)
    s_loc = jnp.einsum('bnqhgd,bnkhd->bnhgqk', qb, kb).astype(jnp.float32) * scale
    s_loc = jnp.where(jnp.asarray(band)[None, :, None, None], s_loc, NEG)
    s_ctx = jnp.einsum('bnqhgd,blhd->bnhgql', qb, k_ctx).astype(jnp.float32) * scale
    s_sink = jnp.broadcast_to(sink.reshape(1, 1, hk, g, 1, 1).astype(jnp.float32), s_loc.shape[:-1] + (1,))
    s = jnp.concatenate([s_loc, s_ctx, s_sink], axis=-1)
    p = jax.nn.softmax(s, axis=-1).astype(v.dtype)
    o = (jnp.einsum('bnhgqk,bnkhd->bnqhgd', p[..., :span], vb)
         + jnp.einsum('bnhgql,blhd->bnqhgd', p[..., span:-1], v_ctx))
    return o.reshape(b, n, hk * g * d)


def odd_context(h, w_in, sink, w_out):
    b, n, _ = h.shape
    q_na, k_na, v_na, q_sw, k_sw, v_sw = odd_split(h @ w_in)
    o_na = attend(q_na[:, :, :, None], k_na, v_na).reshape(b, n, NA_HEADS * HEAD_DIM)
    o_sw = attend(q_sw, k_sw, v_sw, sink).reshape(b, n, SWA_HEADS * HEAD_DIM)
    out = jnp.concatenate([o_na, o_sw], axis=-1) @ w_out
    return out, jnp.stack([k_na, v_na], axis=2), jnp.stack([k_sw, v_sw], axis=2)


def odd_latent(h, na_kv_ctx, sw_kv_ctx, w_in, rpb, sink, w_out):
    b, n, _ = h.shape
    q_na, k_na, v_na, q_sw, k_sw, v_sw = odd_split(h @ w_in)
    na_kv_ctx = na_kv_ctx.astype(h.dtype)
    sw_kv_ctx = sw_kv_ctx.astype(h.dtype)
    o_na = na_latent(q_na, k_na, v_na, na_kv_ctx[:, :, 0], na_kv_ctx[:, :, 1], rpb)
    q_sw = rope_2d(q_sw.reshape(b, n, SWA_HEADS, HEAD_DIM)).reshape(b, n, SWA_KV_HEADS, SWA_GROUP, HEAD_DIM)
    k_sw = rope_2d(k_sw)
    o_sw = swa_latent(q_sw, k_sw, v_sw, sw_kv_ctx[:, :, 0], sw_kv_ctx[:, :, 1], sink)
    return jnp.concatenate([o_na, o_sw], axis=-1) @ w_out


def conv_ffn(h, w_up, conv_w, conv_b, w_down):
    n = h.shape[1]
    u = h @ w_up
    pad = CONV_W // 2
    up = jnp.pad(u, ((0, 0), (pad, pad), (0, 0)))
    u = sum(up[:, j:j + n] * conv_w[j] for j in range(CONV_W)) + conv_b
    a, gt = u[..., :D_FF], u[..., D_FF:]
    return (jax.nn.silu(gt) * a) @ w_down


def setup_inputs(seed: int = 0) -> dict:
    key = jax.random.key(seed)
    ks = iter(jax.random.split(key, 40))

    def nrm(shape, scale=1.0):
        return jax.random.normal(next(ks), shape, jnp.float32) * scale

    def gain(shape):
        return 1.0 + nrm(shape, 0.05)

    return {
        'x_prompt': nrm((BATCH, SEQ, D_MODEL)),
        'x_sample': nrm((DEC_BATCH, DEC_SEQ, D_MODEL)),
        'cache_mla_latent': nrm((DEC_BATCH, N_EVEN, PAST_LEN, KV_LORA + QK_ROPE)),
        'cache_na_kv': nrm((DEC_BATCH, N_ODD, PAST_LEN, 2, NA_HEADS, HEAD_DIM)),
        'cache_swa_kv': nrm((DEC_BATCH, N_ODD, PAST_LEN, 2, SWA_KV_HEADS, HEAD_DIM)),
        'c': nrm((DEC_BATCH, D_MODEL)),
        'c_ctx': nrm((D_MODEL,)),
        'w_mod': nrm((DEPTH, D_MODEL, N_MOD * D_MODEL), 0.5 * D_MODEL ** -0.5),
        'b_mod': nrm((DEPTH, N_MOD * D_MODEL), 0.02),
        'norm_mix': gain((DEPTH, D_MODEL)),
        'norm_ffn': gain((DEPTH, D_MODEL)),
        'norm_final': gain((D_MODEL,)),
        'w_in_even': nrm((N_EVEN, D_MODEL, EVEN_IN), D_MODEL ** -0.5),
        'mla_q_norm': gain((N_EVEN, Q_LORA)),
        'mla_kv_norm': gain((N_EVEN, KV_LORA)),
        'w_uq': nrm((N_EVEN, Q_LORA, MLA_HEADS * (QK_NOPE + QK_ROPE)), Q_LORA ** -0.5),
        'w_ukv': nrm((N_EVEN, KV_LORA, MLA_HEADS * (QK_NOPE + V_DIM)), KV_LORA ** -0.5),
        'w_pool': nrm((N_EVEN, 4, POOL_GROUP, POOL_GROUP), POOL_GROUP ** -0.5),
        'pool_scale': 1.0 + nrm((N_EVEN, POOL_DIM), 0.1),
        'w_out_even': nrm((N_EVEN, MIX_WIDTH, D_MODEL), MIX_WIDTH ** -0.5),
        'w_in_odd': nrm((N_ODD, D_MODEL, ODD_IN), D_MODEL ** -0.5),
        'na_rpb': nrm((N_ODD, NA_HEADS, 2 * NA_KH_MAX - 1, 2 * NA_KW - 1), 0.1),
        'swa_sink': nrm((N_ODD, SWA_HEADS), 0.5),
        'w_out_odd': nrm((N_ODD, MIX_WIDTH, D_MODEL), MIX_WIDTH ** -0.5),
        'w_up': nrm((DEPTH, D_MODEL, 2 * D_FF), D_MODEL ** -0.5),
        'conv_w': nrm((DEPTH, CONV_W, 2 * D_FF), CONV_W ** -0.5),
        'conv_b': nrm((DEPTH, 2 * D_FF), 0.01),
        'w_down': nrm((DEPTH, D_FF, D_MODEL), D_FF ** -0.5),
    }


def reference(x_prompt, x_sample, cache_mla_latent, cache_na_kv, cache_swa_kv, c, c_ctx,
              w_mod, b_mod, norm_mix, norm_ffn, norm_final,
              w_in_even, mla_q_norm, mla_kv_norm, w_uq, w_ukv, w_pool, pool_scale, w_out_even,
              w_in_odd, na_rpb, swa_sink, w_out_odd,
              w_up, conv_w, conv_b, w_down):
    xp, xs = x_prompt, x_sample
    mla_states, na_states, swa_states = [], [], []
    for l in range(DEPTH):
        e = l // 2
        mp = adaln(c_ctx[None, :], w_mod[l], b_mod[l])
        ms = adaln(c, w_mod[l], b_mod[l])
        hp = modulate(rmsnorm(xp, norm_mix[l]), mp[:, 0], mp[:, 1])
        hs = modulate(rmsnorm(xs, norm_mix[l]), ms[:, 0], ms[:, 1])
        if l % 2 == 0:
            op, lat = even_context(hp, w_in_even[e], mla_q_norm[e], mla_kv_norm[e], w_uq[e], w_ukv[e],
                                   w_pool[e], pool_scale[e], w_out_even[e])
            os_ = even_latent(hs, cache_mla_latent[:, e], w_in_even[e], mla_q_norm[e], mla_kv_norm[e],
                              w_uq[e], w_ukv[e], w_pool[e], pool_scale[e], w_out_even[e])
            mla_states.append(lat)
        else:
            op, kv_na, kv_sw = odd_context(hp, w_in_odd[e], swa_sink[e], w_out_odd[e])
            os_ = odd_latent(hs, cache_na_kv[:, e], cache_swa_kv[:, e], w_in_odd[e], na_rpb[e],
                             swa_sink[e], w_out_odd[e])
            na_states.append(kv_na)
            swa_states.append(kv_sw)
        xp = xp + mp[:, 2] * op
        xs = xs + ms[:, 2] * os_
        hp = modulate(rmsnorm(xp, norm_ffn[l]), mp[:, 3], mp[:, 4])
        hs = modulate(rmsnorm(xs, norm_ffn[l]), ms[:, 3], ms[:, 4])
        xp = xp + mp[:, 5] * conv_ffn(hp, w_up[l], conv_w[l], conv_b[l], w_down[l])
        xs = xs + ms[:, 5] * conv_ffn(hs, w_up[l], conv_w[l], conv_b[l], w_down[l])
    y_prompt = rmsnorm(xp, norm_final)
    y_sample = rmsnorm(xs, norm_final)
    new_mla_latent = jnp.stack(mla_states, axis=1)
    new_na_kv = jnp.stack(na_states, axis=1)
    new_swa_kv = jnp.stack(swa_states, axis=1)
    return (y_prompt, y_sample, new_mla_latent, new_na_kv, new_swa_kv)
```

```cpp
#include <hip/hip_runtime.h>
#include <hip/hip_cooperative_groups.h>
#include <cstdio>
#include <cstdint>
namespace cg = cooperative_groups;
namespace pg8 {
#define PG8_LAS __attribute__((address_space(3)))
typedef unsigned short bf16_t;
typedef short bf16x8 __attribute__((ext_vector_type(8)));
typedef float f32x4 __attribute__((ext_vector_type(4)));
typedef unsigned u32x4 __attribute__((ext_vector_type(4)));
constexpr int BM = 256, BK = 64, HALF = 128, HTB = HALF * BK * 2  , STAGE_BYTES = 8 * HTB, NXCD = 8, WGM = 8;

__host__ __device__ __forceinline__ int lds_byte(int r, int c) { const int st = (r >> 4) * 2 + (c >> 5), rr = r & 15, cc = c & 31, ob = rr * 64 + cc * 2; return st * 1024 + (ob ^ (((ob >> 9) & 1) << 5)); }
__host__ __device__ __forceinline__ void stage_rc(int b, int& R, int& C) { const int st = b / 1024, sb = b % 1024, swz = sb ^ (((sb >> 9) & 1) << 5); R = (st >> 1) * 16 + swz / 64; C = (st & 1) * 32 + (swz % 64) / 2; }
__host__ __device__ __forceinline__ int perm32(int rho) { const int n = rho >> 4, i = rho & 15; return 8 * (i >> 2) + 4 * n + (i & 3); }

struct Unit { int pm, pn; };
struct Gemm { const bf16_t* A; const bf16_t* Bt; int M, N, K; };

struct StaticOrder {
    int nM, nN, nwg, G, c;
    __host__ __device__ void init(int M, int N, int G_, int c_) { nM = M / BM; nN = N / BM; nwg = nM * nN; G = G_; c = c_; }
    __host__ __device__ bool next(int i, Unit& u) const {
        const long L = (long)i * G + c; if (L >= nwg) return false;
        int wgid = (int)L; { const int q = nwg / NXCD, r = nwg % NXCD, xcd = wgid % NXCD, off = wgid / NXCD; wgid = (xcd < r ? xcd * (q + 1) : r * (q + 1) + (xcd - r) * q) + off; }
        const int nig = WGM * nN, gid = wgid / nig, fm = gid * WGM, gsz = (nM - fm) < WGM ? (nM - fm) : WGM;
        u.pm = fm + ((wgid % nig) % gsz); u.pn = (wgid % nig) / gsz; return true;
    }
    __device__ __forceinline__ void a_ready(const Unit&) const {}
    __device__ __forceinline__ void done(const Unit&) const {}
    __device__ __forceinline__ size_t a_off(const Unit& u, int K) const { return (size_t)u.pm * BM * K * 2; }
    __device__ __forceinline__ size_t b_off(const Unit& u, int K) const { return (size_t)u.pn * BM * K * 2; }
};

__device__ __forceinline__ unsigned cvt_pk_bf16(float lo, float hi) { unsigned r; asm volatile("v_cvt_pk_bf16_f32 %0, %1, %2" : "=v"(r) : "v"(lo), "v"(hi)); return r; }
typedef float f32x2 __attribute__((ext_vector_type(2)));
__device__ __forceinline__ f32x2 gelu_pk(f32x2 v) {
    const f32x2 av = __builtin_elementwise_abs(v), d = av * 0.2316418882f + 1.0f;
    f32x2 t; t.x = __builtin_amdgcn_rcpf(d.x); t.y = __builtin_amdgcn_rcpf(d.y);
    f32x2 q = t * 0.5307027145f + (-0.7265760135f); q = q * t + 0.7107068705f; q = q * t + (-0.142248368f); q = q * t + 0.127414796f; q = q * t;
    const f32x2 s = (v * v) * (-0.72134752044f);
    f32x2 e; e.x = __builtin_amdgcn_exp2f(s.x); e.y = __builtin_amdgcn_exp2f(s.y);
    const f32x2 m = v * (q * e), r = v - m;
    f32x2 o; o.x = v.x < 0.f ? m.x : r.x; o.y = v.y < 0.f ? m.y : r.y; return o;
}

template <int ACT  > struct EpiBf16 {
    static constexpr bool PERM = true, AFTER_DRAIN = false; static_assert(ACT == 0 || ACT == 1, "EpiBf16: ACT is 0 (none) or 1 (gelu_pk)");
    bf16_t* O; int ldc; const float* bias; int split_cols; size_t split_stride; float scale0;
    __device__ __forceinline__ void operator()(const f32x4 (&acc)[2][2][4][2], const Unit& u, int wr, int wc, int fr, int fq) const {
        const int row0 = u.pm * BM + wr * 64 + fr; int colt = u.pn * BM; bf16_t* base = O;
        float sc = 1.f; if (split_cols) { const int t = colt / split_cols; base += (size_t)t * split_stride; colt -= t * split_cols; if (t == 0) sc = scale0; }
        const int col0 = colt + wc * 32 + 8 * fq, bcol0 = u.pn * BM + wc * 32 + 8 * fq;
        f32x4 bv[2][2];
#pragma unroll
        for (int bj = 0; bj < 2; ++bj)
#pragma unroll
            for (int n = 0; n < 2; ++n) bv[bj][n] = bias ? *(const f32x4*)(bias + bcol0 + bj * HALF + 4 * n) : (f32x4){0.f, 0.f, 0.f, 0.f};
#pragma unroll
        for (int ai = 0; ai < 2; ++ai)
#pragma unroll
            for (int m = 0; m < 4; ++m) { bf16_t* rowp = base + (size_t)(row0 + ai * HALF + m * 16) * ldc + col0;
#pragma unroll
                for (int bj = 0; bj < 2; ++bj) { f32x4 v0 = acc[ai][bj][m][0] + bv[bj][0], v1 = acc[ai][bj][m][1] + bv[bj][1];
                    if (ACT == 1) { f32x2 a = gelu_pk((f32x2){v0[0], v0[1]}), b = gelu_pk((f32x2){v0[2], v0[3]}), c = gelu_pk((f32x2){v1[0], v1[1]}), d = gelu_pk((f32x2){v1[2], v1[3]});
                        v0 = (f32x4){a.x, a.y, b.x, b.y}; v1 = (f32x4){c.x, c.y, d.x, d.y}; }
                    v0 = v0 * sc; v1 = v1 * sc; u32x4 w; w.x = cvt_pk_bf16(v0[0], v0[1]); w.y = cvt_pk_bf16(v0[2], v0[3]); w.z = cvt_pk_bf16(v1[0], v1[1]); w.w = cvt_pk_bf16(v1[2], v1[3]);
                    *(u32x4*)(rowp + bj * HALF) = w; } }
    }
};
template <class Epi, class Sched, bool ALIGN_EPI = false, bool SP2 = false>
__device__ __forceinline__ void gemm_phase(PG8_LAS unsigned char* lds, const Gemm g, const Sched& S, const Epi& E) {
    int tid_o = threadIdx.x; asm volatile("" : "+v"(tid_o));
    const int tid = tid_o, wid = __builtin_amdgcn_readfirstlane(tid >> 6), lane = tid & 63, wr = wid >> 2, wc = wid & 3, fr = lane & 15, fq = lane >> 4;
    const int K = g.K, nt = K / BK;
    unsigned voffA[2], voffB[2];
#pragma unroll
    for (int i = 0; i < 2; ++i) { int R, C; stage_rc(tid * 16 + i * 8192, R, C); const int Rb = Epi::PERM ? ((R & ~31) + perm32(R & 31)) : R;
        voffA[i] = (unsigned)(R * K + C) * 2u; voffB[i] = (unsigned)(Rb * K + C) * 2u; }
    const size_t kstep = (size_t)(BK * 2);
    const size_t hstep = (size_t)HALF * K * 2;
    const size_t tstep = 2 * hstep;
    const unsigned ldsw = (unsigned)wid * 1024u;
    const int aoff = lds_byte(wr * 64 + fr, fq * 8), boff = lds_byte(wc * 32 + fr, fq * 8);
#define PG8_SA(b, h) (((b) * 2 + (h)) * HTB)
#define PG8_SB(b, h) ((4 + (b) * 2 + (h)) * HTB)
#define PG8_STAGE(bufoff, gbase, voff) do { _Pragma("unroll") for (int _i = 0; _i < 2; ++_i) \
        __builtin_amdgcn_global_load_lds((const unsigned*)((const char*)(gbase) + (voff)[_i]), (PG8_LAS unsigned*)(lds + (bufoff) + ldsw + _i * 8192), 16, 0, 0); } while (0)
#define PG8_LDA(dst, b, h) do { _Pragma("unroll") for (int m = 0; m < 4; ++m) _Pragma("unroll") for (int k = 0; k < 2; ++k) dst[m][k] = *(const PG8_LAS bf16x8*)(lds + PG8_SA(b, h) + aoff + m * 2048 + k * 1024); } while (0)
#define PG8_LDB(dst, b, h) do { _Pragma("unroll") for (int n = 0; n < 2; ++n) _Pragma("unroll") for (int k = 0; k < 2; ++k) dst[n][k] = *(const PG8_LAS bf16x8*)(lds + PG8_SB(b, h) + boff + n * 2048 + k * 1024); } while (0)
#define PG8_MMA(ai, bj, At, Bt) do { __builtin_amdgcn_s_setprio(1); _Pragma("unroll") for (int m = 0; m < 4; ++m) _Pragma("unroll") for (int n = 0; n < 2; ++n) _Pragma("unroll") for (int k = 0; k < 2; ++k) \
        acc[ai][bj][m][n] = __builtin_amdgcn_mfma_f32_16x16x32_bf16(Bt[n][k], At[m][k], acc[ai][bj][m][n], 0, 0, 0); __builtin_amdgcn_s_setprio(0); } while (0)
#define PG8_WAIT_V(n) asm volatile("s_waitcnt vmcnt(" #n ")" ::: "memory")
#define PG8_WAIT_L(n) asm volatile("s_waitcnt lgkmcnt(" #n ")" ::: "memory")
#define PG8_BAR __builtin_amdgcn_s_barrier()
#define PG8_SCHED __builtin_amdgcn_sched_barrier(0)
    Unit cur, nxt; int ui = 0;
    if (!S.next(0, cur)) return;
    f32x4 acc[2][2][4][2];
#pragma unroll
    for (int a = 0; a < 2; ++a)
#pragma unroll
        for (int b = 0; b < 2; ++b)
#pragma unroll
            for (int m = 0; m < 4; ++m)
#pragma unroll
                for (int n = 0; n < 2; ++n) acc[a][b][m][n] = (f32x4){0.f, 0.f, 0.f, 0.f};
    bf16x8 At[4][2], B0[2][2], B1[2][2];
    const char* cA = (const char*)g.A + S.a_off(cur, K); const char* cB = (const char*)g.Bt + S.b_off(cur, K);
    S.a_ready(cur);
    if constexpr (SP2) {
        PG8_STAGE(PG8_SB(0, 0), cB, voffB); PG8_STAGE(PG8_SB(0, 1), cB + hstep, voffB); PG8_STAGE(PG8_SA(0, 0), cA, voffA); PG8_STAGE(PG8_SA(0, 1), cA + hstep, voffA);
        if (wr == 1) PG8_BAR;
        PG8_WAIT_V(2); PG8_BAR;
        PG8_STAGE(PG8_SB(1, 0), cB + kstep, voffB); PG8_STAGE(PG8_SA(1, 0), cA + kstep, voffA); PG8_STAGE(PG8_SB(1, 1), cB + hstep + kstep, voffB);
        PG8_WAIT_V(6); PG8_BAR;
    } else {
        PG8_STAGE(PG8_SB(0, 0), cB, voffB); PG8_STAGE(PG8_SA(0, 0), cA, voffA); PG8_STAGE(PG8_SB(0, 1), cB + hstep, voffB); PG8_STAGE(PG8_SA(0, 1), cA + hstep, voffA);
        if (wr == 1) PG8_BAR;
        PG8_WAIT_V(4); PG8_BAR;
        PG8_STAGE(PG8_SB(1, 0), cB + kstep, voffB); PG8_STAGE(PG8_SA(1, 0), cA + kstep, voffA); PG8_STAGE(PG8_SB(1, 1), cB + hstep + kstep, voffB);
        PG8_WAIT_V(6); PG8_BAR;
    }
    for (;;) {
        const bool has_next = S.next(ui + 1, nxt);
        const char* nA = has_next ? (const char*)g.A + S.a_off(nxt, K) : cA; const char* nB = has_next ? (const char*)g.Bt + S.b_off(nxt, K) : cB;
        for (int t = 0; t < nt; t += 2) {
            const bool last = (t == nt - 2);
            const char* a1 = cA + (size_t)(t + 1) * kstep;
            const char* a2 = last ? nA : cA + (size_t)(t + 2) * kstep; const char* b2 = last ? nB : cB + (size_t)(t + 2) * kstep;
            const char* a3 = a2 + kstep; const char* b3 = b2 + kstep;
            if (last && has_next) S.a_ready(nxt);
            if constexpr (SP2) {
            PG8_LDB(B0, 0, 0); PG8_LDB(B1, 0, 1); PG8_SCHED; PG8_LDA(At, 0, 0); PG8_STAGE(PG8_SA(1, 1), a1 + hstep, voffA);
            PG8_WAIT_V(8); PG8_WAIT_L(0); PG8_BAR; PG8_MMA(0, 0, At, B0); PG8_MMA(0, 1, At, B1); PG8_BAR; PG8_SCHED;
            PG8_LDA(At, 0, 1); PG8_STAGE(PG8_SB(0, 0), b2, voffB); PG8_STAGE(PG8_SB(0, 1), b2 + hstep, voffB); PG8_STAGE(PG8_SA(0, 0), a2, voffA);
            PG8_WAIT_V(8); PG8_WAIT_L(0); PG8_BAR; PG8_MMA(1, 0, At, B0); PG8_MMA(1, 1, At, B1); PG8_BAR; PG8_SCHED;
            PG8_LDB(B0, 1, 0); PG8_LDB(B1, 1, 1); PG8_SCHED; PG8_LDA(At, 1, 0); PG8_STAGE(PG8_SA(0, 1), a2 + hstep, voffA);
            PG8_WAIT_V(8); PG8_WAIT_L(0); PG8_BAR; PG8_MMA(0, 0, At, B0); PG8_MMA(0, 1, At, B1); PG8_BAR; PG8_SCHED;
            PG8_LDA(At, 1, 1); PG8_STAGE(PG8_SB(1, 0), b3, voffB); PG8_STAGE(PG8_SB(1, 1), b3 + hstep, voffB); PG8_STAGE(PG8_SA(1, 0), a3, voffA);
            PG8_WAIT_V(8); PG8_WAIT_L(0); PG8_BAR; PG8_MMA(1, 0, At, B0); PG8_MMA(1, 1, At, B1); PG8_BAR; PG8_SCHED;
            } else {
            PG8_LDB(B0, 0, 0); PG8_SCHED; PG8_LDA(At, 0, 0); PG8_STAGE(PG8_SA(1, 1), a1 + hstep, voffA);
            PG8_WAIT_L(8); PG8_BAR; PG8_WAIT_L(0); PG8_MMA(0, 0, At, B0); PG8_BAR; PG8_SCHED;
            PG8_LDB(B1, 0, 1); PG8_STAGE(PG8_SB(0, 0), b2, voffB);
            PG8_BAR; PG8_WAIT_L(0); PG8_MMA(0, 1, At, B1); PG8_BAR;
            PG8_LDA(At, 0, 1); PG8_STAGE(PG8_SA(0, 0), a2, voffA);
            PG8_BAR; PG8_WAIT_L(0); PG8_MMA(1, 0, At, B0); PG8_BAR; PG8_SCHED;
            PG8_STAGE(PG8_SB(0, 1), b2 + hstep, voffB);
            PG8_WAIT_V(6); PG8_BAR; PG8_MMA(1, 1, At, B1); PG8_BAR;
            PG8_LDB(B0, 1, 0); PG8_SCHED; PG8_LDA(At, 1, 0); PG8_STAGE(PG8_SA(0, 1), a2 + hstep, voffA);
            PG8_WAIT_L(8); PG8_BAR; PG8_WAIT_L(0); PG8_MMA(0, 0, At, B0); PG8_BAR; PG8_SCHED;
            PG8_LDB(B1, 1, 1); PG8_STAGE(PG8_SB(1, 0), b3, voffB);
            PG8_BAR; PG8_WAIT_L(0); PG8_MMA(0, 1, At, B1); PG8_BAR;
            PG8_LDA(At, 1, 1); PG8_STAGE(PG8_SA(1, 0), a3, voffA);
            PG8_BAR; PG8_WAIT_L(0); PG8_MMA(1, 0, At, B0); PG8_BAR; PG8_SCHED;
            PG8_STAGE(PG8_SB(1, 1), b3 + hstep, voffB);
            PG8_WAIT_V(6); PG8_BAR; PG8_MMA(1, 1, At, B1); PG8_BAR;
            }
        }
        if constexpr (ALIGN_EPI) { if (wr == 0) PG8_BAR; }
        if constexpr (!Epi::AFTER_DRAIN) { E(acc, cur, wr, wc, fr, fq); S.done(cur); }
        if (!has_next) break;
#pragma unroll
        for (int a = 0; a < 2; ++a)
#pragma unroll
            for (int b = 0; b < 2; ++b)
#pragma unroll
                for (int m = 0; m < 4; ++m)
#pragma unroll
                    for (int n = 0; n < 2; ++n) acc[a][b][m][n] = (f32x4){0.f, 0.f, 0.f, 0.f};
        cur = nxt; cA = nA; cB = nB; ++ui;
        if constexpr (ALIGN_EPI) { if (wr == 1) PG8_BAR; }
    }
    PG8_WAIT_V(0);
    if constexpr (!ALIGN_EPI) { if (wr == 0) PG8_BAR; }
    PG8_BAR;
    if constexpr (Epi::AFTER_DRAIN) { E.fused(acc, cur, wr, wc, fr, fq, lds, wid, lane); S.done(cur); }
#undef PG8_SA
#undef PG8_SB
#undef PG8_STAGE
#undef PG8_LDA
#undef PG8_LDB
#undef PG8_MMA
#undef PG8_WAIT_V
#undef PG8_WAIT_L
#undef PG8_BAR
#undef PG8_SCHED
}
}

typedef unsigned short bf16;
typedef short bf16x8 __attribute__((ext_vector_type(8)));
typedef float f32x4 __attribute__((ext_vector_type(4)));
typedef float f32x16 __attribute__((ext_vector_type(16)));
typedef unsigned u32x4 __attribute__((ext_vector_type(4)));
typedef unsigned u32x2 __attribute__((ext_vector_type(2)));
typedef float f32x2_t __attribute__((ext_vector_type(2)));
typedef __bf16 bf16x2_t __attribute__((ext_vector_type(2)));
#define LAS __attribute__((address_space(3)))

constexpr int DM = 1024, NTOK = 16384, NPR = 8192, DFF = 2816, NKV = NTOK + 2048;
constexpr float EPS = 1e-6f, LOG2E = 1.4426950408889634f;
constexpr size_t MiB = 1u << 20;
constexpr size_t OUT_Y = 0, OUT_LAT = 16777216, OUT_NA = OUT_LAT + 4718592, OUT_SW = OUT_NA + 16777216;
constexpr size_t WS_MODS = 0;
constexpr size_t WS_TAB8 = 1 * MiB;
constexpr size_t WS_TAB16 = 1 * MiB + 65536;
constexpr size_t WS_BAR = 1 * MiB + 262144;
constexpr size_t WS_MODP = 2 * MiB;
constexpr size_t WS_WIN_E = 10 * MiB, WS_WUQ = 14 * MiB, WS_WUK = 16 * MiB, WS_WUV = 17 * MiB, WS_WOUT_E = 18 * MiB;
constexpr size_t WS_WIN_O = 22 * MiB, WS_WV_O = 31 * MiB, WS_WOUT_O = 34 * MiB, WS_WUP = 38 * MiB, WS_WDOWN = 82 * MiB;
constexpr size_t WS_KC_NA = 104 * MiB, WS_VTC_NA = 108 * MiB, WS_KC_SW = 112 * MiB, WS_VTC_SW = 113 * MiB;
constexpr size_t WS_X = 114 * MiB, WS_HN = 178 * MiB, WS_S = 210 * MiB;
constexpr size_t WS_Z = WS_S, WS_QF = WS_S, WS_KNOPE = WS_S + 40 * MiB, WS_VT = WS_S + 67 * MiB, WS_QAN = WS_S + 94 * MiB,
                 WS_LATN = WS_S + 106 * MiB, WS_KR = WS_S + 115 * MiB, WS_MIX = WS_S + 117 * MiB;
constexpr size_t WS_VT_O = WS_S + 72 * MiB;
constexpr size_t WS_ACT = WS_S;
constexpr size_t WS_END = WS_S + 149 * MiB;
constexpr int LDS_BYTES = 147456;

#ifndef ATT_REP
#define ATT_REP 1
#endif
#ifndef PRO_REP
#define PRO_REP 1
#endif
#ifndef SIDE_REP
#define SIDE_REP 1
#endif
#ifndef GEMM_REP
#define GEMM_REP 1
#endif
struct Args { const float* in[28]; float* out; unsigned char* ws; };

__device__ __forceinline__ unsigned pk2(float lo, float hi) { f32x2_t v = {lo, hi}; bf16x2_t b = __builtin_convertvector(v, bf16x2_t); return __builtin_bit_cast(unsigned, b); }
__device__ __forceinline__ float bflo(unsigned u) { return __uint_as_float(u << 16); }
__device__ __forceinline__ float bfhi(unsigned u) { return __uint_as_float(u & 0xffff0000u); }
__device__ __forceinline__ void unpack8(const u32x4 w, float* f) { f[0] = bflo(w.x); f[1] = bfhi(w.x); f[2] = bflo(w.y); f[3] = bfhi(w.y); f[4] = bflo(w.z); f[5] = bfhi(w.z); f[6] = bflo(w.w); f[7] = bfhi(w.w); }
__device__ __forceinline__ u32x4 pack8(const float* f) { u32x4 w; w.x = pk2(f[0], f[1]); w.y = pk2(f[2], f[3]); w.z = pk2(f[4], f[5]); w.w = pk2(f[6], f[7]); return w; }
__device__ __forceinline__ float wave_sum(float v) {
#pragma unroll
    for (int o = 1; o < 64; o <<= 1) v += __shfl_xor(v, o);
    return v;
}
#define LDS_WAIT() asm volatile("s_waitcnt lgkmcnt(0)" ::: "memory")
__device__ __forceinline__ int vec_of_row(int m) { return m < NPR ? 0 : 1 + ((m - NPR) >> 11); }

__device__ __forceinline__ void tr_item(const float* __restrict__ W, int ldw, bf16* __restrict__ WT, int ldt, float* scr, int lane) {
    {
        f32x4 t[8];
#pragma unroll
        for (int i = 0; i < 8; ++i) t[i] = *(const f32x4*)(W + (size_t)(8 * i + (lane >> 3)) * ldw + 4 * (lane & 7));
#pragma unroll
        for (int i = 0; i < 8; ++i) { float* d = scr + (8 * i + (lane >> 3)) * 33 + 4 * (lane & 7); d[0] = t[i].x; d[1] = t[i].y; d[2] = t[i].z; d[3] = t[i].w; }
    }
    LDS_WAIT();
    const int c = lane & 7;
#pragma unroll
    for (int j = 0; j < 4; ++j) { const int n = (lane >> 3) + 8 * j; const float* s = scr + (8 * c) * 33 + n;
        u32x4 o; o.x = pk2(s[0 * 33], s[1 * 33]); o.y = pk2(s[2 * 33], s[3 * 33]); o.z = pk2(s[4 * 33], s[5 * 33]); o.w = pk2(s[6 * 33], s[7 * 33]);
        *(u32x4*)(WT + (size_t)n * ldt + 8 * c) = o; }
    LDS_WAIT();
}
__device__ __forceinline__ void tr_job(int r, const float* src, int ldw, int nblk, int col0, bf16* dst, int ldt, int row0, float* scr, int lane) {
    const int kb = r / nblk, nb = r % nblk;
    tr_item(src + (size_t)(64 * kb) * ldw + col0 + 32 * nb, ldw, dst + (size_t)(row0 + 32 * nb) * ldt + 64 * kb, ldt, scr, lane);
}

struct EpiRes {
    static constexpr bool PERM = false, AFTER_DRAIN = false;
    float* X; const float* gate;
    __device__ __forceinline__ void operator()(const pg8::f32x4 (&acc)[2][2][4][2], const pg8::Unit& u, int wr, int wc, int fr, int fq) const {
        const int rowt = u.pm * 256; const float* gp = gate + (size_t)vec_of_row(rowt) * 6144;
        const int col0 = u.pn * 256 + wc * 32 + 4 * fq;
        f32x4 gv[2][2];
#pragma unroll
        for (int bj = 0; bj < 2; ++bj)
#pragma unroll
            for (int n = 0; n < 2; ++n) gv[bj][n] = *(const f32x4*)(gp + col0 + bj * 128 + n * 16);
#pragma unroll
        for (int ai = 0; ai < 2; ++ai)
#pragma unroll
            for (int m = 0; m < 4; ++m) { float* xr = X + (size_t)(rowt + ai * 128 + wr * 64 + m * 16 + fr) * DM + col0;
#pragma unroll
                for (int bj = 0; bj < 2; ++bj)
#pragma unroll
                    for (int n = 0; n < 2; ++n) { f32x4 x = *(const f32x4*)(xr + bj * 128 + n * 16); x = x + gv[bj][n] * acc[ai][bj][m][n]; *(f32x4*)(xr + bj * 128 + n * 16) = x; } }
    }
};


__device__ __forceinline__ int uprow(int pm) { if (pm < 32) return pm * 256; const int q = pm - 32, b = q / 9, i = q - 9 * b; return NPR + b * 2048 + 254 * i - 1; }
struct UpOrder : pg8::StaticOrder {
    __device__ __forceinline__ size_t a_off(const pg8::Unit& u, int K) const { return (size_t)uprow(u.pm) * K * 2; }
};
struct OddOrder {
    int G, c; size_t a2, b2;
    __device__ __forceinline__ void init(int G_, int c_, size_t a2_, size_t b2_) { G = G_; c = c_; a2 = a2_; b2 = b2_; }
    __device__ __forceinline__ bool next(int i, pg8::Unit& u) const { const int L = i * G + c; if (L >= 768) return false;
        if (L < 576) { u.pm = L & 63; u.pn = L >> 6; } else { const int L2 = L - 576; u.pm = 1000 + (L2 >> 6); u.pn = L2 & 63; }
        return true; }
    __device__ __forceinline__ void a_ready(const pg8::Unit&) const {}
    __device__ __forceinline__ void done(const pg8::Unit&) const {}
    __device__ __forceinline__ size_t a_off(const pg8::Unit& u, int K) const { return u.pm < 1000 ? (size_t)u.pm * 256 * K * 2 : a2 + (size_t)(u.pm - 1000) * 256 * K * 2; }
    __device__ __forceinline__ size_t b_off(const pg8::Unit& u, int K) const { return u.pm < 1000 ? (size_t)u.pn * 256 * K * 2 : b2 + (size_t)u.pn * 256 * K * 2; }
};
struct EpiOdd {
    static constexpr bool PERM = true, AFTER_DRAIN = false;
    pg8::EpiBf16<0> e1, e2;
    __device__ __forceinline__ void operator()(const pg8::f32x4 (&acc)[2][2][4][2], const pg8::Unit& u, int wr, int wc, int fr, int fq) const {
        if (u.pm < 1000) e1(acc, u, wr, wc, fr, fq);
        else { pg8::Unit v = u; v.pm -= 1000; e2(acc, v, wr, wc, fr, fq); }
    }
};
#define PIN_F(x) asm("" : "+v"(x))
#define DPP_B(SRC, CTRL) __builtin_bit_cast(float, __builtin_amdgcn_mov_dpp(__builtin_bit_cast(int, (float)(SRC)), (CTRL), 0xf, 0xf, true))
#define DPP_F(OLD, SRC, CTRL) __builtin_bit_cast(float, __builtin_amdgcn_update_dpp(__builtin_bit_cast(int, (float)(OLD)), __builtin_bit_cast(int, (float)(SRC)), (CTRL), 0xf, 0xf, false))
struct EpiUpConv {
    static constexpr bool PERM = true, AFTER_DRAIN = false;
    bf16* ACT; const float* cw; const float* cb; float* xch;
    __device__ __forceinline__ void operator()(const pg8::f32x4 (&acc_)[2][2][4][2], const pg8::Unit& u, int wr, int wc, int fr, int fq) const {
        pg8::f32x4 (&A)[2][2][4][2] = const_cast<pg8::f32x4 (&)[2][2][4][2]>(acc_);
        const int pm = u.pm; const bool prompt = pm < 32; const int q = pm - 32, i9 = q - 9 * (q / 9);
        const int pos0 = prompt ? 0 : 254 * i9 - 1, L = prompt ? 256 : 2048, grow0 = uprow(pm);
        const int cbase = 32 * wc + 8 * fq;
        if (!prompt) {
#pragma unroll
            for (int ai = 0; ai < 2; ++ai)
#pragma unroll
                for (int m = 0; m < 4; ++m) { const int pos = pos0 + ai * 128 + wr * 64 + m * 16 + fr; const bool ok = (unsigned)pos < (unsigned)L;
#pragma unroll
                    for (int bj = 0; bj < 2; ++bj)
#pragma unroll
                        for (int n = 0; n < 2; ++n) { if (!ok) A[ai][bj][m][n] = (pg8::f32x4){0.f, 0.f, 0.f, 0.f}; } }
        }
#pragma unroll
        for (int ai = 0; ai < 2; ++ai)
#pragma unroll
            for (int bj = 0; bj < 2; ++bj)
#pragma unroll
                for (int n = 0; n < 2; ++n) {
                    if (fr == 0) *(pg8::f32x4*)(xch + ((0 * 2 + ai) * 2 + wr) * 256 + 128 * bj + cbase + 4 * n) = A[ai][bj][0][n];
                    if (fr == 15) *(pg8::f32x4*)(xch + ((1 * 2 + ai) * 2 + wr) * 256 + 128 * bj + cbase + 4 * n) = A[ai][bj][3][n];
                }
        asm volatile("s_waitcnt lgkmcnt(0)" ::: "memory"); __builtin_amdgcn_s_barrier(); asm volatile("" ::: "memory");
        const int fbase = 128 * u.pn + cbase;
#pragma unroll
        for (int n = 0; n < 2; ++n) {
            asm volatile("" ::: "memory");
            const int f = fbase + 4 * n;
            pg8::f32x4 w[2][3], bb[2];
#pragma unroll
            for (int bj = 0; bj < 2; ++bj) { bb[bj] = *(const pg8::f32x4*)(cb + bj * DFF + f);
#pragma unroll
                for (int t = 0; t < 3; ++t) w[bj][t] = *(const pg8::f32x4*)(cw + t * 2 * DFF + bj * DFF + f); }
#pragma unroll
            for (int ai = 0; ai < 2; ++ai) {
                asm volatile("" ::: "memory");
                pg8::f32x4 ab[2], be[2];
#pragma unroll
                for (int bj = 0; bj < 2; ++bj) {
                    const int co = 128 * bj + cbase + 4 * n;
                    if (wr == 1) ab[bj] = *(const pg8::f32x4*)(xch + ((1 * 2 + ai) * 2 + 0) * 256 + co);
                    else if (ai == 1) ab[bj] = *(const pg8::f32x4*)(xch + ((1 * 2 + 0) * 2 + 1) * 256 + co);
                    else ab[bj] = (pg8::f32x4){0.f, 0.f, 0.f, 0.f};
                    if (wr == 0) be[bj] = *(const pg8::f32x4*)(xch + ((0 * 2 + ai) * 2 + 1) * 256 + co);
                    else if (ai == 0) be[bj] = *(const pg8::f32x4*)(xch + ((0 * 2 + 1) * 2 + 0) * 256 + co);
                    else be[bj] = (pg8::f32x4){0.f, 0.f, 0.f, 0.f};
                }
#pragma unroll
                for (int m = 0; m < 4; ++m) {
                    float cv[2][4];
#pragma unroll
                    for (int bj = 0; bj < 2; ++bj)
#pragma unroll
                        for (int k = 0; k < 4; ++k) {
                            const float cur = A[ai][bj][m][n][k];
                            float up, dn;
                            if (m == 0) up = DPP_F(ab[bj][k], cur, 0x111);
                            else { const float t_ = DPP_B(A[ai][bj][m - 1][n][k], 0x10F); up = DPP_F(t_, cur, 0x111); }
                            if (m == 3) dn = DPP_F(be[bj][k], cur, 0x101);
                            else { const float t_ = DPP_B(A[ai][bj][m + 1][n][k], 0x11F); dn = DPP_F(t_, cur, 0x101); }
                            float r_ = __builtin_fmaf(w[bj][1][k], cur, bb[bj][k]); PIN_F(r_);
                            r_ = __builtin_fmaf(w[bj][0][k], up, r_); PIN_F(r_);
                            r_ = __builtin_fmaf(w[bj][2][k], dn, r_); PIN_F(r_);
                            cv[bj][k] = r_;
                        }
                    const int r = ai * 128 + wr * 64 + m * 16 + fr;
                    const bool okout = prompt || (r >= 1 && r <= 254 && pos0 + r < 2048);
                    if (okout) {
                        float o[4];
#pragma unroll
                        for (int k = 0; k < 4; ++k) { float t_ = cv[1][k] * (-LOG2E); PIN_F(t_); float d_ = __builtin_amdgcn_exp2f(t_) + 1.0f; PIN_F(d_);
                            float p_ = cv[0][k] * cv[1][k]; PIN_F(p_); float q_ = p_ * __builtin_amdgcn_rcpf(d_); PIN_F(q_); o[k] = q_; }
                        u32x2 pkd; pkd.x = pk2(o[0], o[1]); pkd.y = pk2(o[2], o[3]);
                        *(u32x2*)(ACT + (size_t)(grow0 + r) * DFF + f) = pkd;
                    }
                }
            }
        }
    }
};

__device__ __forceinline__ void norm_mod_rows(const float* __restrict__ xp, const float* __restrict__ xs, float* __restrict__ Xout, bf16* __restrict__ Hn,
                                              const float* __restrict__ g, const float* __restrict__ modsl, int shift_slot, int gw, int NGW, int lane) {
    for (int m0 = gw; m0 < NTOK / 2; m0 += NGW) {
        f32x4 v[2][4]; float ss[2];
#pragma unroll
        for (int h = 0; h < 2; ++h) { const int m = m0 + h * (NTOK / 2); const float* xr = (m < NPR) ? xp + (size_t)m * DM : xs + (size_t)(m - NPR) * DM; ss[h] = 0.f;
#pragma unroll
            for (int j = 0; j < 4; ++j) v[h][j] = *(const f32x4*)(xr + 4 * (lane + 64 * j)); }
#pragma unroll
        for (int h = 0; h < 2; ++h)
#pragma unroll
            for (int j = 0; j < 4; ++j) ss[h] += (v[h][j].x * v[h][j].x + v[h][j].y * v[h][j].y) + (v[h][j].z * v[h][j].z + v[h][j].w * v[h][j].w);
#pragma unroll
        for (int h = 0; h < 2; ++h) { const int m = m0 + h * (NTOK / 2);
            const float rstd = 1.0f / sqrtf(wave_sum(ss[h]) * (1.0f / DM) + EPS);
            const float* sh = modsl + (size_t)vec_of_row(m) * 6144 + shift_slot * 1024; const float* sc = sh + 1024;
#pragma unroll
            for (int j = 0; j < 4; ++j) { const int col = 4 * (lane + 64 * j);
                const f32x4 gg = *(const f32x4*)(g + col), s4 = *(const f32x4*)(sc + col), h4 = *(const f32x4*)(sh + col);
                const f32x4 hh = v[h][j] * rstd * gg * (s4 + 1.0f) + h4;
                u32x2 w; w.x = pk2(hh.x, hh.y); w.y = pk2(hh.z, hh.w); *(u32x2*)(Hn + (size_t)m * DM + col) = w;
                if (Xout) *(f32x4*)(Xout + (size_t)m * DM + col) = v[h][j]; } }
    }
}
__device__ __forceinline__ void final_norm_rows(const float* __restrict__ X, float* __restrict__ out, const float* __restrict__ g, int gw, int NGW, int lane) {
    for (int m0 = gw; m0 < NTOK / 2; m0 += NGW) {
        f32x4 v[2][4]; float ss[2];
#pragma unroll
        for (int h = 0; h < 2; ++h) { const float* xr = X + (size_t)(m0 + h * (NTOK / 2)) * DM; ss[h] = 0.f;
#pragma unroll
            for (int j = 0; j < 4; ++j) v[h][j] = *(const f32x4*)(xr + 4 * (lane + 64 * j)); }
#pragma unroll
        for (int h = 0; h < 2; ++h)
#pragma unroll
            for (int j = 0; j < 4; ++j) ss[h] += (v[h][j].x * v[h][j].x + v[h][j].y * v[h][j].y) + (v[h][j].z * v[h][j].z + v[h][j].w * v[h][j].w);
#pragma unroll
        for (int h = 0; h < 2; ++h) { const int m = m0 + h * (NTOK / 2); const float rstd = 1.0f / sqrtf(wave_sum(ss[h]) * (1.0f / DM) + EPS);
#pragma unroll
            for (int j = 0; j < 4; ++j) { const int col = 4 * (lane + 64 * j); const f32x4 gg = *(const f32x4*)(g + col); *(f32x4*)(out + (size_t)m * DM + col) = v[h][j] * rstd * gg; } }
    }
}

__device__ __forceinline__ void even_post(const bf16* __restrict__ Z, bf16* __restrict__ QAn, bf16* __restrict__ LATn, bf16* __restrict__ KR, bf16* __restrict__ MIX,
                                          float* __restrict__ out_lat, const float* __restrict__ cache_mla, const float* __restrict__ gq, const float* __restrict__ gkv,
                                          const float* __restrict__ tab8, int e, int gw, int NGW, int lane) {
    for (int m = gw; m < NKV; m += NGW) {
        if (m >= NTOK) {
            const int i = m - NTOK, b = i >> 9, t = i & 511; const float* src = cache_mla + ((size_t)(b * 2 + e) * 512 + t) * 288;
            const f32x4 v = *(const f32x4*)(src + 4 * lane); u32x2 w; w.x = pk2(v.x, v.y); w.y = pk2(v.z, v.w); *(u32x2*)(LATn + (size_t)m * 256 + 4 * lane) = w;
            if (lane < 8) { const f32x4 r = *(const f32x4*)(src + 256 + 4 * lane); u32x2 q; q.x = pk2(r.x, r.y); q.y = pk2(r.z, r.w); *(u32x2*)(KR + (size_t)m * 32 + 4 * lane) = q; }
            continue;
        }
        const bool prompt = m < NPR; const int b = prompt ? (m >> 8) : ((m - NPR) >> 11), t = prompt ? (m & 255) : ((m - NPR) & 2047);
        float f[16];
#pragma unroll
        for (int i = 0; i < 16; ++i) f[i] = 0.f;
        if (lane < 58) { const bf16* zr = Z + (size_t)m * DM + 16 * lane; unpack8(*(const u32x4*)zr, f); unpack8(*(const u32x4*)(zr + 8), f + 8); }
        float ss = 0.f;
#pragma unroll
        for (int i = 0; i < 16; ++i) ss += f[i] * f[i];
        const float ssq = wave_sum(lane < 24 ? ss : 0.f), sskv = wave_sum((lane >= 24 && lane < 40) ? ss : 0.f);
        const float rq = 1.0f / sqrtf(ssq * (1.0f / 384.0f) + EPS), rkv = 1.0f / sqrtf(sskv * (1.0f / 256.0f) + EPS);
        float* olat = out_lat + ((size_t)(b * 2 + e) * 256 + t) * 288;
        if (lane < 24) {
            float o[16];
#pragma unroll
            for (int i = 0; i < 16; ++i) o[i] = f[i] * rq * gq[16 * lane + i];
            bf16* d = QAn + (size_t)m * 384 + 16 * lane; *(u32x4*)d = pack8(o); *(u32x4*)(d + 8) = pack8(o + 8);
        } else if (lane < 40) {
            const int c0 = 16 * (lane - 24); float o[16];
#pragma unroll
            for (int i = 0; i < 16; ++i) o[i] = f[i] * rkv * gkv[c0 + i];
            bf16* d = LATn + (size_t)m * 256 + c0; *(u32x4*)d = pack8(o); *(u32x4*)(d + 8) = pack8(o + 8);
            if (prompt) {
#pragma unroll
                for (int i = 0; i < 4; ++i) *(f32x4*)(olat + c0 + 4 * i) = (f32x4){o[4 * i], o[4 * i + 1], o[4 * i + 2], o[4 * i + 3]};
            }
        } else if (lane < 42) {
            const int half = lane - 40; float o[16];
            if (prompt) {
#pragma unroll
                for (int i = 0; i < 16; ++i) o[i] = f[i];
#pragma unroll
                for (int i = 0; i < 4; ++i) *(f32x4*)(olat + 256 + 16 * half + 4 * i) = (f32x4){o[4 * i], o[4 * i + 1], o[4 * i + 2], o[4 * i + 3]};
            } else {
                const int pos = half == 0 ? (t >> 6) : (t & 63);
#pragma unroll
                for (int i = 0; i < 8; ++i) { const float c = tab8[(pos * 8 + i) * 2], s = tab8[(pos * 8 + i) * 2 + 1]; o[i] = f[i] * c - f[i + 8] * s; o[i + 8] = f[i] * s + f[i + 8] * c; }
            }
            bf16* d = KR + (size_t)m * 32 + 16 * half; *(u32x4*)d = pack8(o); *(u32x4*)(d + 8) = pack8(o + 8);
        }
    }
}

__device__ __forceinline__ void pool_rows(const bf16* __restrict__ Z, bf16* __restrict__ MIX, int gtid, int NGT) {
    for (int idx = gtid; idx < NTOK * 16; idx += NGT) {
        const int m = idx >> 4, cl = idx & 15, g = cl >> 2, hw = 1 << g;
        const bool prompt = m < NPR; const int t = prompt ? (m & 255) : ((m - NPR) & 2047), n = prompt ? 256 : 2048;
        const int lo = (t - hw) > 0 ? (t - hw) : 0, hi = (t + hw) < n ? (t + hw) : n;
        const bf16* zc = Z + (size_t)(m - t) * DM + 672 + 16 * cl;
        float f[16], a[16];
        { const bf16* zr = zc + (size_t)t * DM; unpack8(*(const u32x4*)zr, f); unpack8(*(const u32x4*)(zr + 8), f + 8); }
#pragma unroll
        for (int i = 0; i < 16; ++i) a[i] = 0.f;
#pragma unroll
        for (int bt = 0; bt < 2; ++bt) {
            if (bt * 8 < hi - lo) {
                u32x4 q0[8], q1[8];
#pragma unroll
                for (int j = 0; j < 8; ++j) { int s_ = lo + bt * 8 + j; s_ = s_ < hi ? s_ : hi - 1; const bf16* zr = zc + (size_t)s_ * DM; q0[j] = *(const u32x4*)zr; q1[j] = *(const u32x4*)(zr + 8); }
#pragma unroll
                for (int j = 0; j < 8; ++j) { const float wv = (lo + bt * 8 + j) < hi ? 1.0f : 0.0f; float q[16]; unpack8(q0[j], q); unpack8(q1[j], q + 8);
#pragma unroll
                    for (int i = 0; i < 16; ++i) a[i] += wv * q[i]; }
            }
        }
        const float inv = 1.0f / (float)(hi - lo);
#pragma unroll
        for (int i = 0; i < 16; ++i) a[i] = a[i] * inv - f[i];
        bf16* d = MIX + (size_t)m * DM + 768 + 16 * cl; *(u32x4*)d = pack8(a); *(u32x4*)(d + 8) = pack8(a + 8);
    }
}

__device__ __forceinline__ void odd_post(bf16* __restrict__ Z, float* __restrict__ out_na, float* __restrict__ out_sw, const float* __restrict__ tab16, int e, int gw, int NGW, int lane) {
    for (int m = gw; m < NTOK; m += NGW) {
        bf16* zr = Z + (size_t)m * 2304;
        if (m < NPR) {
            const int b = m >> 8, t = m & 255; float f[16];
            { unpack8(*(const u32x4*)(zr + 512 + 16 * lane), f); unpack8(*(const u32x4*)(zr + 512 + 16 * lane + 8), f + 8);
              float* o = out_na + ((size_t)(b * 2 + e) * 256 + t) * 1024 + 16 * lane;
#pragma unroll
              for (int i = 0; i < 4; ++i) *(f32x4*)(o + 4 * i) = (f32x4){f[4 * i], f[4 * i + 1], f[4 * i + 2], f[4 * i + 3]}; }
            if (lane < 16) { unpack8(*(const u32x4*)(zr + 2048 + 16 * lane), f); unpack8(*(const u32x4*)(zr + 2048 + 16 * lane + 8), f + 8);
              float* o = out_sw + ((size_t)(b * 2 + e) * 256 + t) * 256 + 16 * lane;
#pragma unroll
              for (int i = 0; i < 4; ++i) *(f32x4*)(o + 4 * i) = (f32x4){f[4 * i], f[4 * i + 1], f[4 * i + 2], f[4 * i + 3]}; }
        } else if (lane < 4) {
            const int t = (m - NPR) & 2047, half = lane & 1, pos = half == 0 ? (t >> 6) : (t & 63);
            bf16* p = zr + 2048 + 32 * lane; float f[32], o[32];
#pragma unroll
            for (int i = 0; i < 4; ++i) unpack8(*(const u32x4*)(p + 8 * i), f + 8 * i);
#pragma unroll
            for (int i = 0; i < 16; ++i) { const float c = tab16[(pos * 16 + i) * 2], s = tab16[(pos * 16 + i) * 2 + 1]; o[i] = f[i] * c - f[i + 16] * s; o[i + 16] = f[i] * s + f[i + 16] * c; }
#pragma unroll
            for (int i = 0; i < 4; ++i) *(u32x4*)(p + 8 * i) = pack8(o + 8 * i);
        }
    }
}

template <int MODE>
__device__ __forceinline__ void mask_scale(f32x16& s, int kb  , int qpos, float scale, float sl2, const float* __restrict__ rpb, float& mx) {
#pragma unroll
    for (int r = 0; r < 16; ++r) {
        float v;
        if constexpr (MODE == 0) { v = s[r]; }
        else {
            const int kpos = kb + 16 * (r >> 3) + (r & 7);
            if constexpr (MODE == 1) {
                const int krow = kpos >> 6, kcol = kpos & 63, qrow = qpos >> 6, qcol = qpos & 63;
                int qcs = qcol - 8; qcs = qcs < 0 ? 0 : (qcs > 48 ? 48 : qcs);
                const bool valid = (kcol >= qcs) && (kcol < qcs + 16);
                int dc = kcol - qcol + 15; dc = dc < 0 ? 0 : (dc > 30 ? 30 : dc);
                int dr = krow - qrow + 7; dr = dr < 0 ? 0 : (dr > 14 ? 14 : dr);
                const float bias = rpb[dr * 31 + dc];
                const bool rowok = (krow - qrow + 7 >= 0) && (krow - qrow + 7 <= 14);
                v = (valid && rowok) ? (s[r] * scale + bias) * LOG2E : -INFINITY;
            } else {
                const int d = qpos - kpos; const bool valid = (d <= 128) && (d >= -128);
                v = valid ? s[r] * sl2 : -INFINITY;
            }
        }
        s[r] = v; mx = fmaxf(mx, v);
    }
}

template <int DQ, int MODE  , bool ROPE, bool MLA>
__device__ __forceinline__ void attn_block(
    const bf16* __restrict__ Qp, int qld, int qpos0,
    const bf16* __restrict__ K0, int k0ld, const bf16* __restrict__ K0r, const bf16* __restrict__ V0t, int v0ld, int s0row, int s0nt, int s0pos,
    const bf16* __restrict__ K1, int k1ld, const bf16* __restrict__ K1r, const bf16* __restrict__ V1t, int v1ld, int s1row, int s1nt,
    int my_lo, int my_hi, int na_r0  ,
    float scale, bool has_sink, float sink, const float* __restrict__ rpb, const float* __restrict__ tab,
    bf16* __restrict__ Op, int old, unsigned char* ldsb, int wave, int tid_in)
{
    int tid = tid_in; asm volatile("" : "+v"(tid));
    constexpr int NC = DQ / 16, QLD = DQ + 8, HALF = DQ / 2, KRS = DQ * 2 + 16, VRS = 144, KBUF = 64 * KRS, VBUF = 64 * VRS, STG = KBUF + VBUF;
    const int lane = tid & 63, r32 = lane & 31, hi = lane >> 5;
    bf16* qs = (bf16*)(ldsb + wave * 6656);
    unsigned char* kv = ldsb + 53248;
    const int lrow = tid >> 3, lch = tid & 7;
    u32x4 gk, gr, gv, hk, hr, hv;
    gr = (u32x4){0, 0, 0, 0}; hr = gr;
#define AB_GLOAD(T, GK, GR, GV) do { const int t_ = (T); const bool in1_ = t_ >= s0nt; const int tt_ = in1_ ? t_ - s0nt : t_; const int krow_ = (in1_ ? s1row : s0row) + 64 * tt_; \
        GK = *(const u32x4*)((in1_ ? K1 : K0) + (size_t)(krow_ + lrow) * (in1_ ? k1ld : k0ld) + 8 * lch); \
        if constexpr (MLA) { if (tid < 256) GR = *(const u32x4*)((in1_ ? K1r : K0r) + (size_t)(krow_ + (tid >> 2)) * 32 + 8 * (tid & 3)); } \
        GV = *(const u32x4*)((in1_ ? V1t : V0t) + (size_t)lrow * (in1_ ? v1ld : v0ld) + krow_ + 8 * lch); } while (0)
#define AB_LSTORE(B, GK, GR, GV) do { unsigned char* kb_ = kv + (B) * STG; *(u32x4*)(kb_ + lrow * KRS + 16 * lch) = GK; \
        if constexpr (MLA) { if (tid < 256) *(u32x4*)(kb_ + (tid >> 2) * KRS + 128 + 16 * (tid & 3)) = GR; } \
        *(u32x4*)(kb_ + KBUF + lrow * VRS + 16 * lch) = GV; } while (0)
    const int nt_e = s0nt + s1nt;
    AB_GLOAD(0, gk, gr, gv); if (nt_e > 1) AB_GLOAD(1, hk, hr, hv);
    {
        const bf16* src = Qp + (size_t)r32 * qld + hi * HALF;
        float f[HALF];
#pragma unroll
        for (int i = 0; i < HALF / 8; ++i) unpack8(*(const u32x4*)(src + 8 * i), f + 8 * i);
        if constexpr (ROPE) {
            const int qp_ = qpos0 + r32;
            if constexpr (MLA) {
                if (hi == 1) {
                    const int pr_ = qp_ >> 6, pc_ = qp_ & 63;
#pragma unroll
                    for (int i = 0; i < 8; ++i) {
                        const float c = tab[(pr_ * 8 + i) * 2], s = tab[(pr_ * 8 + i) * 2 + 1]; const float x1 = f[16 + i], x2 = f[24 + i]; f[16 + i] = x1 * c - x2 * s; f[24 + i] = x1 * s + x2 * c;
                        const float c2 = tab[(pc_ * 8 + i) * 2], s2 = tab[(pc_ * 8 + i) * 2 + 1]; const float y1 = f[32 + i], y2 = f[40 + i]; f[32 + i] = y1 * c2 - y2 * s2; f[40 + i] = y1 * s2 + y2 * c2;
                    }
                }
            } else {
                const int pos = hi == 0 ? (qp_ >> 6) : (qp_ & 63);
#pragma unroll
                for (int i = 0; i < 16; ++i) { const float c = tab[(pos * 16 + i) * 2], s = tab[(pos * 16 + i) * 2 + 1]; const float x1 = f[i], x2 = f[16 + i]; f[i] = x1 * c - x2 * s; f[16 + i] = x1 * s + x2 * c; }
            }
        }
#pragma unroll
        for (int i = 0; i < HALF / 8; ++i) *(u32x4*)(qs + r32 * QLD + hi * HALF + 8 * i) = pack8(f + 8 * i);
    }
    LDS_WAIT();
    bf16x8 qf[NC];
#pragma unroll
    for (int c = 0; c < NC; ++c) qf[c] = *(const bf16x8*)(qs + r32 * QLD + 16 * c + 8 * hi);
    LDS_WAIT();
    const int pr = (r32 & ~12) | ((r32 & 4) << 1) | ((r32 & 8) >> 1);
    f32x16 o0, o1;
#pragma unroll
    for (int r = 0; r < 16; ++r) { o0[r] = 0.f; o1[r] = 0.f; }
    float mrun = -1e30f, lrun = 0.f;
    const int nt = s0nt + s1nt;
    const float sl2 = scale * LOG2E;
    const int qpos = qpos0 + r32;
#define AB_ACT(T) ((MODE == 0) || ((T) >= s0nt) || ((T) >= my_lo && (T) <= my_hi))
#define AB_QK(T, SA, SB) do { const unsigned char* kq_ = kv + ((T) % 3) * STG; \
        _Pragma("unroll") for (int r = 0; r < 16; ++r) { SA[r] = 0.f; SB[r] = 0.f; } \
        _Pragma("unroll") for (int c = 0; c < NC; ++c) { \
            const bf16x8 ka_ = *(const bf16x8*)(kq_ + pr * KRS + (16 * c + 8 * hi) * 2); \
            const bf16x8 kc_ = *(const bf16x8*)(kq_ + (32 + pr) * KRS + (16 * c + 8 * hi) * 2); \
            SA = __builtin_amdgcn_mfma_f32_32x32x16_bf16(ka_, qf[c], SA, 0, 0, 0); \
            SB = __builtin_amdgcn_mfma_f32_32x32x16_bf16(kc_, qf[c], SB, 0, 0, 0); } } while (0)
#define AB_STEP(T, SA, SB, NA_, NB_, GK, GR, GV) do { const int t = (T); \
        if (t + 2 < nt) AB_LSTORE((t + 2) % 3, GK, GR, GV); \
        if (t + 4 < nt) AB_GLOAD(t + 4, GK, GR, GV); \
        if (t + 1 < nt && AB_ACT(t + 1)) AB_QK(t + 1, NA_, NB_); \
        if (AB_ACT(t)) { \
            const unsigned char* vb = kv + (t % 3) * STG + KBUF; \
            float mx = -INFINITY, mulf; \
            if (MODE != 0 && t < s0nt) { const int kb0 = s0pos + 64 * t + 8 * hi; \
                mask_scale<MODE>(SA, kb0, qpos, scale, sl2, rpb, mx); mask_scale<MODE>(SB, kb0 + 32, qpos, scale, sl2, rpb, mx); mulf = 1.0f; } \
            else { mask_scale<0>(SA, 0, qpos, scale, sl2, rpb, mx); mask_scale<0>(SB, 0, qpos, scale, sl2, rpb, mx); mx *= sl2; mulf = sl2; } \
            mx = fmaxf(mx, __shfl_xor(mx, 32)); \
            const float mnew = fmaxf(mrun, mx), alpha = __builtin_amdgcn_exp2f(mrun - mnew); mrun = mnew; \
            float ps = 0.f; \
            _Pragma("unroll") for (int r = 0; r < 16; ++r) { const float p = __builtin_amdgcn_exp2f(__builtin_fmaf(SA[r], mulf, -mnew)); SA[r] = p; ps += p; } \
            _Pragma("unroll") for (int r = 0; r < 16; ++r) { const float p = __builtin_amdgcn_exp2f(__builtin_fmaf(SB[r], mulf, -mnew)); SB[r] = p; ps += p; } \
            lrun = lrun * alpha + ps; \
            if (__any(alpha != 1.0f)) { _Pragma("unroll") for (int r = 0; r < 16; ++r) { o0[r] *= alpha; o1[r] *= alpha; } } \
            u32x4 w0, w1, w2, w3; \
            w0.x = pk2(SA[0], SA[1]); w0.y = pk2(SA[2], SA[3]); w0.z = pk2(SA[4], SA[5]); w0.w = pk2(SA[6], SA[7]); \
            w1.x = pk2(SA[8], SA[9]); w1.y = pk2(SA[10], SA[11]); w1.z = pk2(SA[12], SA[13]); w1.w = pk2(SA[14], SA[15]); \
            w2.x = pk2(SB[0], SB[1]); w2.y = pk2(SB[2], SB[3]); w2.z = pk2(SB[4], SB[5]); w2.w = pk2(SB[6], SB[7]); \
            w3.x = pk2(SB[8], SB[9]); w3.y = pk2(SB[10], SB[11]); w3.z = pk2(SB[12], SB[13]); w3.w = pk2(SB[14], SB[15]); \
            const bf16x8 p0 = __builtin_bit_cast(bf16x8, w0), p1 = __builtin_bit_cast(bf16x8, w1), p2 = __builtin_bit_cast(bf16x8, w2), p3 = __builtin_bit_cast(bf16x8, w3); \
            const unsigned char* va = vb + r32 * VRS + 16 * hi; const unsigned char* vc = va + 32 * VRS; \
            o0 = __builtin_amdgcn_mfma_f32_32x32x16_bf16(*(const bf16x8*)(va), p0, o0, 0, 0, 0); \
            o1 = __builtin_amdgcn_mfma_f32_32x32x16_bf16(*(const bf16x8*)(vc), p0, o1, 0, 0, 0); \
            o0 = __builtin_amdgcn_mfma_f32_32x32x16_bf16(*(const bf16x8*)(va + 32), p1, o0, 0, 0, 0); \
            o1 = __builtin_amdgcn_mfma_f32_32x32x16_bf16(*(const bf16x8*)(vc + 32), p1, o1, 0, 0, 0); \
            o0 = __builtin_amdgcn_mfma_f32_32x32x16_bf16(*(const bf16x8*)(va + 64), p2, o0, 0, 0, 0); \
            o1 = __builtin_amdgcn_mfma_f32_32x32x16_bf16(*(const bf16x8*)(vc + 64), p2, o1, 0, 0, 0); \
            o0 = __builtin_amdgcn_mfma_f32_32x32x16_bf16(*(const bf16x8*)(va + 96), p3, o0, 0, 0, 0); \
            o1 = __builtin_amdgcn_mfma_f32_32x32x16_bf16(*(const bf16x8*)(vc + 96), p3, o1, 0, 0, 0); \
        } \
        asm volatile("s_waitcnt lgkmcnt(0)\n\ts_barrier" ::: "memory"); } while (0)
    f32x16 sA, sB, sC, sD;
    AB_LSTORE(0, gk, gr, gv); if (nt > 1) AB_LSTORE(1, hk, hr, hv);
    if (nt > 2) AB_GLOAD(2, gk, gr, gv);
    if (nt > 3) AB_GLOAD(3, hk, hr, hv);
    asm volatile("s_waitcnt lgkmcnt(0)\n\ts_barrier" ::: "memory");
    if (AB_ACT(0)) AB_QK(0, sA, sB);
    for (int tt = 0; tt < nt; tt += 2) {
        AB_STEP(tt, sA, sB, sC, sD, gk, gr, gv);
        if (tt + 1 < nt) AB_STEP(tt + 1, sC, sD, sA, sB, hk, hr, hv);
    }
#undef AB_STEP
#undef AB_QK
#undef AB_ACT
#undef AB_GLOAD
#undef AB_LSTORE
    lrun += __shfl_xor(lrun, 32);
    if (has_sink) lrun += __builtin_amdgcn_exp2f(sink * LOG2E - mrun);
    const float inv = 1.0f / lrun;
    bf16* op = Op + (size_t)r32 * old + 4 * hi;
#pragma unroll
    for (int g = 0; g < 4; ++g) {
        u32x2 a; a.x = pk2(o0[4 * g] * inv, o0[4 * g + 1] * inv); a.y = pk2(o0[4 * g + 2] * inv, o0[4 * g + 3] * inv); *(u32x2*)(op + 8 * g) = a;
        u32x2 b; b.x = pk2(o1[4 * g] * inv, o1[4 * g + 1] * inv); b.y = pk2(o1[4 * g + 2] * inv, o1[4 * g + 3] * inv); *(u32x2*)(op + 32 + 8 * g) = b;
    }
}


#define XB_TMO      128
#define XB_XCNT(j)  (256  + 64 * (j))
#define XB_XSUB(j)  (1280 + 64 * (j))
#define XB_XGEN(j)  (2304 + 64 * (j))
#define XB_TOP      3328
#define XB_TOPGEN   3392
#define XCD_BAR_WORDS 3456
#define XB_SPIN_CAP (1u << 18)

__device__ __forceinline__ unsigned xb_ld(unsigned* p)              { return __hip_atomic_load(p, __ATOMIC_RELAXED, __HIP_MEMORY_SCOPE_AGENT); }
__device__ __forceinline__ unsigned xb_add(unsigned* p, unsigned v) { return __hip_atomic_fetch_add(p, v, __ATOMIC_RELAXED, __HIP_MEMORY_SCOPE_AGENT); }
__device__ __forceinline__ unsigned xb_xcc_id() { return (unsigned)__builtin_amdgcn_s_getreg((3 << 11) | 20) & 0xFu; }
#define XB_SPIN(cond, bar) do { unsigned _sp = 0; while (cond) { __builtin_amdgcn_s_sleep(1); \
    if ((++_sp & 255u) == 0u) { if (xb_ld(&(bar)[XB_TMO])) break; if (_sp > XB_SPIN_CAP) { atomicAdd(&(bar)[XB_TMO], 1u); break; } } } } while (0)

struct XcdBarrier {
    unsigned* bar; unsigned x;
    volatile LAS unsigned* st;
};

__device__ __forceinline__ XcdBarrier xcd_barrier_post(unsigned* bar, volatile LAS unsigned* st) {
    XcdBarrier b; b.bar = bar; b.x = xb_xcc_id(); b.st = st;
    if (threadIdx.x == 0) (void)xb_add(&bar[XB_XCNT(b.x)], 1u);
    return b;
}
__device__ __forceinline__ void xcd_barrier_complete(unsigned* bar, unsigned x, unsigned& nloc, unsigned& nx) {
    const unsigned G = gridDim.x * gridDim.y * gridDim.z;
    unsigned sum, cnt, mine, sp = 0u;
    for (;;) {
        sum = 0u; cnt = 0u; mine = 0u;
#pragma nounroll
        for (unsigned j = 0; j < 16; ++j) { const unsigned c = xb_ld(&bar[XB_XCNT(j)]); sum += c; cnt += (c > 0u) ? 1u : 0u; mine = (j == x) ? c : mine; }
        if (sum == G) break;
        __builtin_amdgcn_s_sleep(1);
        if ((++sp & 255u) == 0u) { if (xb_ld(&bar[XB_TMO])) break; if (sp > XB_SPIN_CAP) { atomicAdd(&bar[XB_TMO], 1u); break; } }
    }
    nloc = mine > 0u ? mine : 1u; nx = cnt > 0u ? cnt : 1u;
}

__device__ __forceinline__ void xcd_barrier(const XcdBarrier& b) {
    asm volatile("s_waitcnt vmcnt(0)" ::: "memory");
    __syncthreads();
    if (threadIdx.x == 0) {
        unsigned* bar = b.bar; const unsigned bx = (unsigned)__builtin_amdgcn_readfirstlane((int)xb_xcc_id());
        __builtin_amdgcn_s_waitcnt(0);
        unsigned nloc = b.st[0], nx = b.st[1];
        if (nloc == 0u) { xcd_barrier_complete(bar, bx, nloc, nx); b.st[0] = nloc; b.st[1] = nx; }
        const unsigned old = xb_add(&bar[XB_XSUB(bx)], 1u);
        const unsigned gen = old / nloc;
        if (old + 1u == (gen + 1u) * nloc) {
            __builtin_amdgcn_fence(__ATOMIC_RELEASE, "agent");
            asm volatile("s_waitcnt vmcnt(0)" ::: "memory");
            const unsigned og = xb_add(&bar[XB_TOP], 1u);
            const unsigned tg = og / nx;
            if (og + 1u == (tg + 1u) * nx) xb_add(&bar[XB_TOPGEN], 1u);
            else XB_SPIN(xb_ld(&bar[XB_TOPGEN]) == tg, bar);
            __builtin_amdgcn_fence(__ATOMIC_ACQUIRE, "agent");
            xb_add(&bar[XB_XGEN(bx)], 1u);
            asm volatile("s_waitcnt vmcnt(0)" ::: "memory");
        } else {
            XB_SPIN(xb_ld(&bar[XB_XGEN(bx)]) == gen, bar);
            __builtin_amdgcn_fence(__ATOMIC_ACQUIRE, "agent");
            asm volatile("s_waitcnt vmcnt(0)" ::: "memory");
        }
    }
    __syncthreads();
}

#define GEMM_BF16(Aptr, Bptr, Mv, Nv, Kv, Optr, LDC) do { \
    pg8::Gemm g_{(const pg8::bf16_t*)(Aptr), (const pg8::bf16_t*)(Bptr), (Mv), (Nv), (Kv)}; pg8::StaticOrder S_; S_.init((Mv), (Nv), G, (int)blockIdx.x); \
    pg8::EpiBf16<0> E_{(pg8::bf16_t*)(Optr), (LDC), nullptr, 0, 0, 1.f}; \
    for (int rep_ = 0; rep_ < GEMM_REP; ++rep_) pg8::gemm_phase<pg8::EpiBf16<0>, pg8::StaticOrder, true, true>(ldsg, g_, S_, E_); } while (0)
#define GEMM_RES(Aptr, Bptr, Kv, GATE) do { \
    pg8::Gemm g_{(const pg8::bf16_t*)(Aptr), (const pg8::bf16_t*)(Bptr), NTOK, DM, (Kv)}; pg8::StaticOrder S_; S_.init(NTOK, DM, G, (int)blockIdx.x); \
    EpiRes E_{X, (GATE)}; \
    pg8::gemm_phase<EpiRes, pg8::StaticOrder, true, true>(ldsg, g_, S_, E_); } while (0)

__global__ void __launch_bounds__(512) fwd_kernel(Args a) {
    extern __shared__ __attribute__((aligned(16))) unsigned char lds[];
    cg::grid_group grid = cg::this_grid();
    PG8_LAS unsigned char* ldsg = (PG8_LAS unsigned char*)lds;
    const int wave = __builtin_amdgcn_readfirstlane((int)threadIdx.x >> 6);
    const int G = gridDim.x, gw = blockIdx.x * 8 + wave, NGW = G * 8, NGT = G * 512;
#define FRESH() int tid = threadIdx.x; asm volatile("" : "+v"(tid)); const int lane = tid & 63, gtid = blockIdx.x * 512 + tid; (void)lane; (void)gtid
    unsigned char* ws = a.ws;
    float* mods = (float*)(ws + WS_MODS); float* tab8 = (float*)(ws + WS_TAB8); float* tab16 = (float*)(ws + WS_TAB16); float* modp = (float*)(ws + WS_MODP);
    bf16* WIN_E = (bf16*)(ws + WS_WIN_E); bf16* WUQ = (bf16*)(ws + WS_WUQ); bf16* WUK = (bf16*)(ws + WS_WUK); bf16* WUV = (bf16*)(ws + WS_WUV); bf16* WOUT_E = (bf16*)(ws + WS_WOUT_E);
    bf16* WIN_O = (bf16*)(ws + WS_WIN_O); bf16* WV_O = (bf16*)(ws + WS_WV_O); bf16* WOUT_O = (bf16*)(ws + WS_WOUT_O); bf16* WUP = (bf16*)(ws + WS_WUP); bf16* WDOWN = (bf16*)(ws + WS_WDOWN);
    bf16* KC_NA = (bf16*)(ws + WS_KC_NA); bf16* VTC_NA = (bf16*)(ws + WS_VTC_NA); bf16* KC_SW = (bf16*)(ws + WS_KC_SW); bf16* VTC_SW = (bf16*)(ws + WS_VTC_SW);
    float* X = (float*)(ws + WS_X); bf16* HN = (bf16*)(ws + WS_HN);
    bf16* Z = (bf16*)(ws + WS_Z); bf16* QF = (bf16*)(ws + WS_QF); bf16* KNOPE = (bf16*)(ws + WS_KNOPE); bf16* VT = (bf16*)(ws + WS_VT); bf16* QAN = (bf16*)(ws + WS_QAN);
    bf16* LATN = (bf16*)(ws + WS_LATN); bf16* KR = (bf16*)(ws + WS_KR); bf16* MIX = (bf16*)(ws + WS_MIX); bf16* VT_O = (bf16*)(ws + WS_VT_O);
    bf16* ACT = (bf16*)(ws + WS_ACT);
    float* scr = (float*)(lds + wave * 16384);
    volatile LAS unsigned* bst = (volatile LAS unsigned*)((LAS unsigned char*)lds + 131072 + 512);
    if (threadIdx.x < 2) bst[threadIdx.x] = 0u;
    __syncthreads();
    const XcdBarrier bar = xcd_barrier_post((unsigned*)(ws + WS_BAR), bst);
#define GSYNC() xcd_barrier(bar)

#ifndef SKIP_PRO
    for (int prorep = 0; prorep < PRO_REP; ++prorep) {
        FRESH();
        constexpr int I1 = 16 * 29, I2 = 6 * 36, I3 = 4 * 48, I4 = 12 * 32, I5 = 16 * 72, I6a = 16 * 16, I6b = 16 * 4, I7 = 16 * 32, IE = I1 + I2 + I3 + I4 + I5 + I6a + I6b + I7;
        constexpr int IV1 = 8 * 16, IV2 = 8 * 4;
        constexpr int IU = 16 * 176, ID = 44 * 32;
        constexpr int NIT = 2 * IE + 8 * IV1 + 8 * IV2;
        for (int it = gw; it < NIT; it += NGW) {
            int r = it;
            if (r >= 2 * IE + 8 * IV1 + 8 * IV2) {
                continue;
            }
            if (r < 2 * IE) {
                const int e = r / IE; r -= e * IE;
                if (r < I1) { tr_job(r, a.in[12] + (size_t)e * 1024 * 928, 928, 29, 0, WIN_E + (size_t)e * 1024 * 1024, 1024, 0, scr, lane); continue; } r -= I1;
                if (r < I2) { tr_job(r, a.in[15] + (size_t)e * 384 * 1152, 1152, 36, 0, WUQ + (size_t)e * 1280 * 384, 384, 0, scr, lane); continue; } r -= I2;
                if (r < I3) { const int kb = r / 48, nb = r % 48, n0 = 32 * nb, h = n0 >> 7, j0 = n0 & 127;
                    bf16* dst = (j0 >= 64 ? WUV : WUK) + (size_t)e * 768 * 256 + (size_t)(h * 64 + (j0 & 63)) * 256 + 64 * kb;
                    tr_item(a.in[16] + (size_t)e * 256 * 1536 + (size_t)(64 * kb) * 1536 + n0, 1536, dst, 256, scr, lane); continue; } r -= I3;
                if (r < I4) { tr_job(r, a.in[19] + (size_t)e * 1024 * 1024, 1024, 32, 0, WOUT_E + (size_t)e * 1024 * 1024, 1024, 0, scr, lane); continue; } r -= I4;
                if (r < I5) { tr_job(r, a.in[20] + (size_t)e * 1024 * 2304, 2304, 72, 0, WIN_O + (size_t)e * 2304 * 1024, 1024, 0, scr, lane); continue; } r -= I5;
                if (r < I6a) { tr_job(r, a.in[20] + (size_t)e * 1024 * 2304, 2304, 16, 1024, WV_O + (size_t)e * 768 * 1024, 1024, 0, scr, lane); continue; } r -= I6a;
                if (r < I6b) { tr_job(r, a.in[20] + (size_t)e * 1024 * 2304, 2304, 4, 2176, WV_O + (size_t)e * 768 * 1024, 1024, 512, scr, lane); continue; } r -= I6b;
                tr_job(r, a.in[23] + (size_t)e * 1024 * 1024, 1024, 32, 0, WOUT_O + (size_t)e * 1024 * 1024, 1024, 0, scr, lane); continue;
            }
            r -= 2 * IE;
            if (r < 8 * IV1) { const int eb = r / IV1, q = r % IV1, e = eb >> 2, b = eb & 3, kb = q / 16, nb = q % 16;
                tr_item(a.in[3] + ((size_t)(b * 2 + e) * 512 + 64 * kb) * 1024 + 512 + 32 * nb, 1024, VTC_NA + (size_t)e * 512 * 2048 + (size_t)(32 * nb) * 2048 + b * 512 + 64 * kb, 2048, scr, lane); continue; }
            r -= 8 * IV1;
            { const int eb = r / IV2, q = r % IV2, e = eb >> 2, b = eb & 3, kb = q / 4, nb = q % 4;
                tr_item(a.in[4] + ((size_t)(b * 2 + e) * 512 + 64 * kb) * 256 + 128 + 32 * nb, 256, VTC_SW + (size_t)e * 128 * 2048 + (size_t)(32 * nb) * 2048 + b * 512 + 64 * kb, 2048, scr, lane); }
        }
        for (int i = gtid; i < 2 * 96 * 1024 / 8; i += NGT) { const int e = i / (96 * 128), q = i % (96 * 128); *(u32x4*)(WIN_E + (size_t)e * 1024 * 1024 + (size_t)928 * 1024 + 8 * q) = (u32x4){0, 0, 0, 0}; }
        for (int i = gtid; i < 2 * 128 * 384 / 8; i += NGT) { const int e = i / (128 * 48), q = i % (128 * 48); *(u32x4*)(WUQ + (size_t)e * 1280 * 384 + (size_t)1152 * 384 + 8 * q) = (u32x4){0, 0, 0, 0}; }
        for (int i = gtid; i < 2 * 128 * 1024 / 8; i += NGT) { const int e = i / (128 * 128), q = i % (128 * 128); *(u32x4*)(WV_O + (size_t)e * 768 * 1024 + (size_t)640 * 1024 + 8 * q) = (u32x4){0, 0, 0, 0}; }
        for (int i = gtid; i < 2 * 256 * 1024; i += NGT) { const int n = i & 1023, gc = (i >> 10) & 255, e = i >> 18, g = gc >> 6;
            const float* wp = a.in[17] + ((size_t)e * 4 * 64 * 64) + (size_t)gc * 64; const float* psc = a.in[18] + e * 256 + g * 64; const float* wo = a.in[19] + (size_t)e * 1024 * 1024 + (size_t)(768 + g * 64) * 1024 + n;
            float s = 0.f;
            for (int d = 0; d < 64; ++d) s += wp[d] * psc[d] * wo[(size_t)d * 1024];
            WOUT_E[(size_t)e * 1024 * 1024 + (size_t)n * 1024 + 768 + gc] = (bf16)(pk2(s, 0.f) & 0xffffu); }
        for (int i = gtid; i < 2 * 2048 * 512 / 4; i += NGT) { const int c4 = i & 127, row = (i >> 7) & 2047, e = i >> 18, b = row >> 9, t = row & 511;
            const f32x4 v = *(const f32x4*)(a.in[3] + ((size_t)(b * 2 + e) * 512 + t) * 1024 + 4 * c4); u32x2 w; w.x = pk2(v.x, v.y); w.y = pk2(v.z, v.w);
            *(u32x2*)(KC_NA + (size_t)e * 2048 * 512 + (size_t)row * 512 + 4 * c4) = w; }
        for (int i = gtid; i < 2 * 2048 * 128 / 4; i += NGT) { const int c4 = i & 31, row = (i >> 5) & 2047, e = i >> 16, b = row >> 9, t = row & 511;
            const f32x4 v = *(const f32x4*)(a.in[4] + ((size_t)(b * 2 + e) * 512 + t) * 256 + 4 * c4); u32x2 w; w.x = pk2(v.x, v.y); w.y = pk2(v.z, v.w);
            *(u32x2*)(KC_SW + (size_t)e * 2048 * 128 + (size_t)row * 128 + 4 * c4) = w; }
        for (int i = gtid; i < 64 * 8; i += NGT) { const int pos = i >> 3, k = i & 7; const float fr = powf(10000.0f, -(float)k / 8.0f), ang = (float)pos * fr; tab8[2 * i] = cosf(ang); tab8[2 * i + 1] = sinf(ang); }
        for (int i = gtid; i < 64 * 16; i += NGT) { const int pos = i >> 4, k = i & 15; const float fr = powf(10000.0f, -(float)k / 16.0f), ang = (float)pos * fr; tab16[2 * i] = cosf(ang); tab16[2 * i + 1] = sinf(ang); }
        __syncthreads();
        float* sv = (float*)lds;
        for (int it = blockIdx.x; it < 4 * 16 * 12; it += G) {
            const int jg = it % 12, kc = (it / 12) & 15, l = it / 192;
            if (tid < 320) { const int v = tid >> 6, k = tid & 63; const float x = v == 0 ? a.in[6][kc * 64 + k] : a.in[5][(v - 1) * 1024 + kc * 64 + k]; sv[tid] = x / (1.0f + __expf(-x)); }
            __syncthreads();
            const int j = jg * 512 + tid; const float* wm = a.in[7] + (size_t)l * 1024 * 6144 + (size_t)(kc * 64) * 6144 + j;
            float s0 = 0.f, s1 = 0.f, s2 = 0.f, s3 = 0.f, s4 = 0.f;
#pragma unroll 16
            for (int k = 0; k < 64; ++k) { const float w = wm[(size_t)k * 6144]; s0 += sv[k] * w; s1 += sv[64 + k] * w; s2 += sv[128 + k] * w; s3 += sv[192 + k] * w; s4 += sv[256 + k] * w; }
            float* mp = modp + ((size_t)(l * 16 + kc) * 5) * 6144 + j;
            mp[0] = s0; mp[6144] = s1; mp[2 * 6144] = s2; mp[3 * 6144] = s3; mp[4 * 6144] = s4;
            __syncthreads();
        }
    }
#endif
    grid.sync();
    { FRESH();
    for (int i = gtid; i < 4 * 5 * 6144; i += NGT) { const int j = i % 6144, lv = i / 6144, l = lv / 5, v = lv % 5;
        float s = a.in[8][l * 6144 + j];
        for (int kc = 0; kc < 16; ++kc) s += modp[((size_t)(l * 16 + kc) * 5 + v) * 6144 + j];
        mods[i] = s; } }
    GSYNC();

    for (int l = 0; l < 4; ++l) {
        const int e = l >> 1; const float* modsl = mods + (size_t)l * 5 * 6144;
        {
            FRESH();
            {
            if (l == 0) norm_mod_rows(a.in[0], a.in[1], X, HN, a.in[9] + l * 1024, modsl, 0, gw, NGW, lane);
            else norm_mod_rows(X, X + (size_t)NPR * DM, nullptr, HN, a.in[9] + l * 1024, modsl, 0, gw, NGW, lane);
            }
        }
        GSYNC();
        if ((l & 1) == 0) {
            GEMM_BF16(HN, WIN_E + (size_t)e * 1024 * 1024, NTOK, 1024, 1024, Z, 1024);
            GSYNC();
#ifndef SKIP_POST
            { FRESH(); for (int rep_ = 0; rep_ < SIDE_REP; ++rep_) even_post(Z, QAN, LATN, KR, MIX, a.out + OUT_LAT, a.in[2], a.in[13] + e * 384, a.in[14] + e * 256, tab8, e, gw, NGW, lane); pool_rows(Z, MIX, gtid, NGT); }
#endif
            GSYNC();
            GEMM_BF16(QAN, WUQ + (size_t)e * 1280 * 384, NTOK, 1280, 384, QF, 1280);
            GEMM_BF16(LATN, WUK + (size_t)e * 768 * 256, NKV, 768, 256, KNOPE, 768);
            GEMM_BF16(WUV + (size_t)e * 768 * 256, LATN, 768, NKV, 256, VT, NKV);
            GSYNC();
#ifndef SKIP_ATTN
            {
                FRESH();
                const float scale = 0.10206207261596575f;
                for (int rep = 0; rep < ATT_REP; ++rep)
                for (int u = blockIdx.x; u < 768; u += G) {
                    if (u < 384) { const int blk = u & 7, h = (u >> 3) % 12, b = u / 96; const int m0 = NPR + b * 2048 + blk * 256 + wave * 32;
                        attn_block<96, 0, true, true>(QF + (size_t)m0 * 1280 + h * 96, 1280, blk * 256 + wave * 32,
                            KNOPE + h * 64, 768, KR, VT + (size_t)(h * 64) * NKV, NKV, NPR + b * 2048, 32, 0,
                            KNOPE + h * 64, 768, KR, VT + (size_t)(h * 64) * NKV, NKV, NTOK + b * 512, 8,
                            0, 0, 0, scale, false, 0.f, nullptr, tab8, MIX + (size_t)m0 * DM + h * 64, DM, lds, wave, tid);
                    } else { const int v = u - 384, h = v % 12, b = v / 12; const int m0 = b * 256 + wave * 32;
                        attn_block<96, 0, false, true>(QF + (size_t)m0 * 1280 + h * 96, 1280, wave * 32,
                            KNOPE + h * 64, 768, KR, VT + (size_t)(h * 64) * NKV, NKV, b * 256, 4, 0,
                            KNOPE + h * 64, 768, KR, VT + (size_t)(h * 64) * NKV, NKV, 0, 0,
                            0, 0, 0, scale, false, 0.f, nullptr, tab8, MIX + (size_t)m0 * DM + h * 64, DM, lds, wave, tid);
                    }
                }
                if (l == 0 && (int)blockIdx.x >= G / 2) {
                    constexpr int IU = 16 * 176, ID = 44 * 32;
                    const int cw_ = ((int)blockIdx.x - G / 2) * 8 + wave, ncw_ = (G - G / 2) * 8;
                    for (int it = cw_; it < 4 * (IU + ID); it += ncw_) {
                        const int ll = it / (IU + ID); const int r = it - ll * (IU + ID);
                        if (r < IU) { const int kb = r / 176, nb = r % 176, n0 = 32 * nb, f = n0 < DFF ? n0 : n0 - DFF, row = (f >> 7) * 256 + (n0 >= DFF ? 128 : 0) + (f & 127);
                            tr_item(a.in[24] + (size_t)ll * 1024 * 5632 + (size_t)(64 * kb) * 5632 + n0, 5632, WUP + (size_t)ll * 5632 * 1024 + (size_t)row * 1024 + 64 * kb, 1024, scr, lane); }
                        else tr_job(r - IU, a.in[27] + (size_t)ll * DFF * 1024, 1024, 32, 0, WDOWN + (size_t)ll * 1024 * DFF, DFF, 0, scr, lane);
                    }
                }
            }
#endif
            GSYNC();
            GEMM_RES(MIX, WOUT_E + (size_t)e * 1024 * 1024, 1024, modsl + 2 * 1024);
        } else {
            { const bf16* win = WIN_O + (size_t)e * 2304 * 1024; const bf16* wv = WV_O + (size_t)e * 768 * 1024;
              pg8::Gemm g_{(const pg8::bf16_t*)HN, (const pg8::bf16_t*)win, NTOK, 2304, 1024};
              OddOrder S_; S_.init(G, (int)blockIdx.x, (size_t)((const char*)wv - (const char*)HN), (size_t)((const char*)HN - (const char*)win));
              EpiOdd E_{pg8::EpiBf16<0>{(pg8::bf16_t*)Z, 2304, nullptr, 0, 0, 1.f}, pg8::EpiBf16<0>{(pg8::bf16_t*)VT_O, NTOK, nullptr, 0, 0, 1.f}};
              pg8::gemm_phase<EpiOdd, OddOrder, true, true>(ldsg, g_, S_, E_); }
            GSYNC();
#ifndef SKIP_POST
            { FRESH(); odd_post(Z, a.out + OUT_NA, a.out + OUT_SW, tab16, e, gw, NGW, lane); }
#endif
            GSYNC();
#ifndef SKIP_ATTN
            {
                FRESH();
                const float scale = 0.125f;
                const bf16* kcna = KC_NA + (size_t)e * 2048 * 512; const bf16* vtcna = VTC_NA + (size_t)e * 512 * 2048;
                const bf16* kcsw = KC_SW + (size_t)e * 2048 * 128; const bf16* vtcsw = VTC_SW + (size_t)e * 128 * 2048;
                for (int rep = 0; rep < ATT_REP; ++rep)
                for (int u = blockIdx.x; u < 1024; u += G) {
                    const int kind = u >> 8, v = u & 255;
                    if (kind == 0) {
                        const int blk = v & 7, h = (v >> 3) & 7, b = v >> 6; const int gr0 = 4 * blk, gr = gr0 + (wave >> 1), qp0 = gr * 64 + (wave & 1) * 32, m0 = NPR + b * 2048 + qp0;
                        int rlo = gr0 - 4; rlo = rlo < 0 ? 0 : (rlo > 24 ? 24 : rlo);
                        int rhi = gr0 - 1; rhi = (rhi < 0 ? 0 : (rhi > 24 ? 24 : rhi)) + 7;
                        int r0 = gr - 4; r0 = r0 < 0 ? 0 : (r0 > 24 ? 24 : r0);
                        attn_block<64, 1, false, false>(Z + (size_t)m0 * 2304 + h * 64, 2304, qp0,
                            Z + 512 + h * 64, 2304, nullptr, VT_O + (size_t)(h * 64) * NTOK, NTOK, NPR + b * 2048 + rlo * 64, rhi - rlo + 1, rlo * 64,
                            kcna + h * 64, 512, nullptr, vtcna + (size_t)(h * 64) * 2048, 2048, b * 512, 8,
                            r0 - rlo, r0 - rlo + 7, r0, scale, false, 0.f, a.in[21] + ((size_t)e * 8 + h) * 15 * 31, tab16, MIX + (size_t)m0 * DM + h * 64, DM, lds, wave, tid);
                    } else if (kind == 1) {
                        const int blk = v & 7, hq = (v >> 3) & 7, b = v >> 6, hk = hq >> 2; const int qt = 8 * blk + wave, qp0 = qt * 32, m0 = NPR + b * 2048 + qp0;
                        const int tlo = 4 * blk - 2 < 0 ? 0 : 4 * blk - 2, thi = 4 * blk + 5 > 31 ? 31 : 4 * blk + 5;
                        const int wlo = (qt - 4 < 0 ? 0 : qt - 4) >> 1, whi = (qt + 4 > 63 ? 63 : qt + 4) >> 1;
                        attn_block<64, 2, true, false>(Z + (size_t)m0 * 2304 + 1536 + hq * 64, 2304, qp0,
                            Z + 2048 + hk * 64, 2304, nullptr, VT_O + (size_t)(512 + hk * 64) * NTOK, NTOK, NPR + b * 2048 + tlo * 64, thi - tlo + 1, tlo * 64,
                            kcsw + hk * 64, 128, nullptr, vtcsw + (size_t)(hk * 64) * 2048, 2048, b * 512, 8,
                            wlo - tlo, whi - tlo, 0, scale, true, a.in[22][e * 8 + hq], nullptr, tab16, MIX + (size_t)m0 * DM + 512 + hq * 64, DM, lds, wave, tid);
                    } else if (kind == 2) {
                        const int h = v & 7, b = v >> 3; const int m0 = b * 256 + wave * 32;
                        attn_block<64, 0, false, false>(Z + (size_t)m0 * 2304 + h * 64, 2304, wave * 32,
                            Z + 512 + h * 64, 2304, nullptr, VT_O + (size_t)(h * 64) * NTOK, NTOK, b * 256, 4, 0,
                            Z + 512 + h * 64, 2304, nullptr, VT_O + (size_t)(h * 64) * NTOK, NTOK, 0, 0,
                            0, 0, 0, scale, false, 0.f, nullptr, tab16, MIX + (size_t)m0 * DM + h * 64, DM, lds, wave, tid);
                    } else {
                        const int hq = v & 7, b = v >> 3, hk = hq >> 2; const int m0 = b * 256 + wave * 32;
                        attn_block<64, 0, false, false>(Z + (size_t)m0 * 2304 + 1536 + hq * 64, 2304, wave * 32,
                            Z + 2048 + hk * 64, 2304, nullptr, VT_O + (size_t)(512 + hk * 64) * NTOK, NTOK, b * 256, 4, 0,
                            Z + 2048 + hk * 64, 2304, nullptr, VT_O + (size_t)(512 + hk * 64) * NTOK, NTOK, 0, 0,
                            0, 0, 0, scale, true, a.in[22][e * 8 + hq], nullptr, tab16, MIX + (size_t)m0 * DM + 512 + hq * 64, DM, lds, wave, tid);
                    }
                }
            }
#endif
            GSYNC();
            GEMM_RES(MIX, WOUT_O + (size_t)e * 1024 * 1024, 1024, modsl + 2 * 1024);
        }
        GSYNC();
        { FRESH(); for (int rep_ = 0; rep_ < SIDE_REP; ++rep_) norm_mod_rows(X, X + (size_t)NPR * DM, nullptr, HN, a.in[10] + l * 1024, modsl, 3, gw, NGW, lane); }
        GSYNC();
        { pg8::Gemm g_{(const pg8::bf16_t*)HN, (const pg8::bf16_t*)(WUP + (size_t)l * 5632 * 1024), 68 * 256, 5632, 1024}; UpOrder S_; S_.init(68 * 256, 5632, G, (int)blockIdx.x);
          EpiUpConv E_{ACT, a.in[25] + (size_t)l * 3 * 5632, a.in[26] + (size_t)l * 5632, (float*)(lds + 131072 + 1024)};
          pg8::gemm_phase<EpiUpConv, UpOrder, true, true>(ldsg, g_, S_, E_); }
        GSYNC();
        GEMM_RES(ACT, WDOWN + (size_t)l * 1024 * DFF, DFF, modsl + 5 * 1024);
        GSYNC();
    }
    { FRESH(); int gwf = gw; asm volatile("" : "+s"(gwf)); final_norm_rows(X, a.out + OUT_Y, a.in[11], gwf, NGW, lane); }
}

extern "C" void kernel_launch(void* const* d_in, const int* in_sizes, int n_in, void* d_out, int out_size, void* d_ws, size_t ws_size, hipStream_t stream) {
    static int grid = 0;
    if (grid == 0) {
        if (n_in != 28 || ws_size < WS_END) { fprintf(stderr, "kernel_launch: unexpected n_in %d / ws_size %zu (need %zu)\n", n_in, ws_size, (size_t)WS_END); grid = -1; return; }
        int dev = 0, cus = 0, per_cu = 0;
        (void)hipGetDevice(&dev); (void)hipDeviceGetAttribute(&cus, hipDeviceAttributeMultiprocessorCount, dev);
        if (hipFuncSetAttribute((const void*)fwd_kernel, hipFuncAttributeMaxDynamicSharedMemorySize, LDS_BYTES) != hipSuccess) { fprintf(stderr, "kernel_launch: hipFuncSetAttribute failed\n"); grid = -1; return; }
        if (hipOccupancyMaxActiveBlocksPerMultiprocessor(&per_cu, (const void*)fwd_kernel, 512, LDS_BYTES) != hipSuccess || per_cu < 1) { fprintf(stderr, "kernel_launch: occupancy query says %d\n", per_cu); per_cu = 1; }
        (void)hipGetLastError();
        grid = cus * 1;
        if (grid <= 0) grid = 256;
    }
    if (grid < 0) return;
    if (hipMemsetAsync((unsigned char*)d_ws + WS_BAR, 0, 16384, stream) != hipSuccess) { fprintf(stderr, "kernel_launch: memset failed\n"); return; }
    Args a{};
    for (int i = 0; i < 28; ++i) a.in[i] = (const float*)d_in[i];
    a.out = (float*)d_out; a.ws = (unsigned char*)d_ws;
    void* args[] = {&a};
    hipError_t e = hipLaunchCooperativeKernel((const void*)fwd_kernel, dim3(grid), dim3(512), args, LDS_BYTES, stream);
    if (e != hipSuccess) fprintf(stderr, "cooperative launch failed: %s (grid %d)\n", hipGetErrorString(e), grid);
}
```

```cpp
#include <hip/hip_runtime.h>
#include <hip/hip_cooperative_groups.h>
#include <cstdio>
#include <cstdint>
namespace cg = cooperative_groups;
namespace pg8 {
#define PG8_LAS __attribute__((address_space(3)))
typedef unsigned short bf16_t;
typedef short bf16x8 __attribute__((ext_vector_type(8)));
typedef float f32x4 __attribute__((ext_vector_type(4)));
typedef unsigned u32x4 __attribute__((ext_vector_type(4)));
constexpr int BM = 256, BK = 64, HALF = 128, HTB = HALF * BK * 2  , STAGE_BYTES = 8 * HTB, NXCD = 8, WGM = 8;

__host__ __device__ __forceinline__ int lds_byte(int r, int c) { const int st = (r >> 4) * 2 + (c >> 5), rr = r & 15, cc = c & 31, ob = rr * 64 + cc * 2; return st * 1024 + (ob ^ (((ob >> 9) & 1) << 5)); }
__host__ __device__ __forceinline__ void stage_rc(int b, int& R, int& C) { const int st = b / 1024, sb = b % 1024, swz = sb ^ (((sb >> 9) & 1) << 5); R = (st >> 1) * 16 + swz / 64; C = (st & 1) * 32 + (swz % 64) / 2; }
__host__ __device__ __forceinline__ int perm32(int rho) { const int n = rho >> 4, i = rho & 15; return 8 * (i >> 2) + 4 * n + (i & 3); }

struct Unit { int pm, pn; };
struct Gemm { const bf16_t* A; const bf16_t* Bt; int M, N, K; };

struct StaticOrder {
    int nM, nN, nwg, G, c;
    __host__ __device__ void init(int M, int N, int G_, int c_) { nM = M / BM; nN = N / BM; nwg = nM * nN; G = G_; c = c_; }
    __host__ __device__ bool next(int i, Unit& u) const {
        const long L = (long)i * G + c; if (L >= nwg) return false;
        int wgid = (int)L; { const int q = nwg / NXCD, r = nwg % NXCD, xcd = wgid % NXCD, off = wgid / NXCD; wgid = (xcd < r ? xcd * (q + 1) : r * (q + 1) + (xcd - r) * q) + off; }
        const int nig = WGM * nN, gid = wgid / nig, fm = gid * WGM, gsz = (nM - fm) < WGM ? (nM - fm) : WGM;
        u.pm = fm + ((wgid % nig) % gsz); u.pn = (wgid % nig) / gsz; return true;
    }
    __device__ __forceinline__ void a_ready(const Unit&) const {}
    __device__ __forceinline__ void done(const Unit&) const {}
    __device__ __forceinline__ size_t a_off(const Unit& u, int K) const { return (size_t)u.pm * BM * K * 2; }
    __device__ __forceinline__ size_t b_off(const Unit& u, int K) const { return (size_t)u.pn * BM * K * 2; }
};

__device__ __forceinline__ unsigned cvt_pk_bf16(float lo, float hi) { unsigned r; asm volatile("v_cvt_pk_bf16_f32 %0, %1, %2" : "=v"(r) : "v"(lo), "v"(hi)); return r; }
typedef float f32x2 __attribute__((ext_vector_type(2)));
__device__ __forceinline__ f32x2 gelu_pk(f32x2 v) {
    const f32x2 av = __builtin_elementwise_abs(v), d = av * 0.2316418882f + 1.0f;
    f32x2 t; t.x = __builtin_amdgcn_rcpf(d.x); t.y = __builtin_amdgcn_rcpf(d.y);
    f32x2 q = t * 0.5307027145f + (-0.7265760135f); q = q * t + 0.7107068705f; q = q * t + (-0.142248368f); q = q * t + 0.127414796f; q = q * t;
    const f32x2 s = (v * v) * (-0.72134752044f);
    f32x2 e; e.x = __builtin_amdgcn_exp2f(s.x); e.y = __builtin_amdgcn_exp2f(s.y);
    const f32x2 m = v * (q * e), r = v - m;
    f32x2 o; o.x = v.x < 0.f ? m.x : r.x; o.y = v.y < 0.f ? m.y : r.y; return o;
}

template <int ACT  > struct EpiBf16 {
    static constexpr bool PERM = true, AFTER_DRAIN = false; static_assert(ACT == 0 || ACT == 1, "EpiBf16: ACT is 0 (none) or 1 (gelu_pk)");
    bf16_t* O; int ldc; const float* bias; int split_cols; size_t split_stride; float scale0;
    __device__ __forceinline__ void operator()(const f32x4 (&acc)[2][2][4][2], const Unit& u, int wr, int wc, int fr, int fq) const {
        const int row0 = u.pm * BM + wr * 64 + fr; int colt = u.pn * BM; bf16_t* base = O;
        float sc = 1.f; if (split_cols) { const int t = colt / split_cols; base += (size_t)t * split_stride; colt -= t * split_cols; if (t == 0) sc = scale0; }
        const int col0 = colt + wc * 32 + 8 * fq, bcol0 = u.pn * BM + wc * 32 + 8 * fq;
        f32x4 bv[2][2];
#pragma unroll
        for (int bj = 0; bj < 2; ++bj)
#pragma unroll
            for (int n = 0; n < 2; ++n) bv[bj][n] = bias ? *(const f32x4*)(bias + bcol0 + bj * HALF + 4 * n) : (f32x4){0.f, 0.f, 0.f, 0.f};
#pragma unroll
        for (int ai = 0; ai < 2; ++ai)
#pragma unroll
            for (int m = 0; m < 4; ++m) { bf16_t* rowp = base + (size_t)(row0 + ai * HALF + m * 16) * ldc + col0;
#pragma unroll
                for (int bj = 0; bj < 2; ++bj) { f32x4 v0 = acc[ai][bj][m][0] + bv[bj][0], v1 = acc[ai][bj][m][1] + bv[bj][1];
                    if (ACT == 1) { f32x2 a = gelu_pk((f32x2){v0[0], v0[1]}), b = gelu_pk((f32x2){v0[2], v0[3]}), c = gelu_pk((f32x2){v1[0], v1[1]}), d = gelu_pk((f32x2){v1[2], v1[3]});
                        v0 = (f32x4){a.x, a.y, b.x, b.y}; v1 = (f32x4){c.x, c.y, d.x, d.y}; }
                    v0 = v0 * sc; v1 = v1 * sc; u32x4 w; w.x = cvt_pk_bf16(v0[0], v0[1]); w.y = cvt_pk_bf16(v0[2], v0[3]); w.z = cvt_pk_bf16(v1[0], v1[1]); w.w = cvt_pk_bf16(v1[2], v1[3]);
                    *(u32x4*)(rowp + bj * HALF) = w; } }
    }
};
template <class Epi, class Sched, bool ALIGN_EPI = false, bool SP2 = false>
__device__ __forceinline__ void gemm_phase(PG8_LAS unsigned char* lds, const Gemm g, const Sched& S, const Epi& E) {
    int tid_o = threadIdx.x; asm volatile("" : "+v"(tid_o));
    const int tid = tid_o, wid = __builtin_amdgcn_readfirstlane(tid >> 6), lane = tid & 63, wr = wid >> 2, wc = wid & 3, fr = lane & 15, fq = lane >> 4;
    const int K = g.K, nt = K / BK;
    unsigned voffA[2], voffB[2];
#pragma unroll
    for (int i = 0; i < 2; ++i) { int R, C; stage_rc(tid * 16 + i * 8192, R, C); const int Rb = Epi::PERM ? ((R & ~31) + perm32(R & 31)) : R;
        voffA[i] = (unsigned)(R * K + C) * 2u; voffB[i] = (unsigned)(Rb * K + C) * 2u; }
    const size_t kstep = (size_t)(BK * 2);
    const size_t hstep = (size_t)HALF * K * 2;
    const size_t tstep = 2 * hstep;
    const unsigned ldsw = (unsigned)wid * 1024u;
    const int aoff = lds_byte(wr * 64 + fr, fq * 8), boff = lds_byte(wc * 32 + fr, fq * 8);
#define PG8_SA(b, h) (((b) * 2 + (h)) * HTB)
#define PG8_SB(b, h) ((4 + (b) * 2 + (h)) * HTB)
#define PG8_STAGE(bufoff, gbase, voff) do { _Pragma("unroll") for (int _i = 0; _i < 2; ++_i) \
        __builtin_amdgcn_global_load_lds((const unsigned*)((const char*)(gbase) + (voff)[_i]), (PG8_LAS unsigned*)(lds + (bufoff) + ldsw + _i * 8192), 16, 0, 0); } while (0)
#define PG8_LDA(dst, b, h) do { _Pragma("unroll") for (int m = 0; m < 4; ++m) _Pragma("unroll") for (int k = 0; k < 2; ++k) dst[m][k] = *(const PG8_LAS bf16x8*)(lds + PG8_SA(b, h) + aoff + m * 2048 + k * 1024); } while (0)
#define PG8_LDB(dst, b, h) do { _Pragma("unroll") for (int n = 0; n < 2; ++n) _Pragma("unroll") for (int k = 0; k < 2; ++k) dst[n][k] = *(const PG8_LAS bf16x8*)(lds + PG8_SB(b, h) + boff + n * 2048 + k * 1024); } while (0)
#define PG8_MMA(ai, bj, At, Bt) do { __builtin_amdgcn_s_setprio(1); _Pragma("unroll") for (int m = 0; m < 4; ++m) _Pragma("unroll") for (int n = 0; n < 2; ++n) _Pragma("unroll") for (int k = 0; k < 2; ++k) \
        acc[ai][bj][m][n] = __builtin_amdgcn_mfma_f32_16x16x32_bf16(Bt[n][k], At[m][k], acc[ai][bj][m][n], 0, 0, 0); __builtin_amdgcn_s_setprio(0); } while (0)
#define PG8_WAIT_V(n) asm volatile("s_waitcnt vmcnt(" #n ")" ::: "memory")
#define PG8_WAIT_L(n) asm volatile("s_waitcnt lgkmcnt(" #n ")" ::: "memory")
#define PG8_BAR __builtin_amdgcn_s_barrier()
#define PG8_SCHED __builtin_amdgcn_sched_barrier(0)
    Unit cur, nxt; int ui = 0;
    if (!S.next(0, cur)) return;
    f32x4 acc[2][2][4][2];
#pragma unroll
    for (int a = 0; a < 2; ++a)
#pragma unroll
        for (int b = 0; b < 2; ++b)
#pragma unroll
            for (int m = 0; m < 4; ++m)
#pragma unroll
                for (int n = 0; n < 2; ++n) acc[a][b][m][n] = (f32x4){0.f, 0.f, 0.f, 0.f};
    bf16x8 At[4][2], B0[2][2], B1[2][2];
    const char* cA = (const char*)g.A + S.a_off(cur, K); const char* cB = (const char*)g.Bt + S.b_off(cur, K);
    S.a_ready(cur);
    if constexpr (SP2) {
        PG8_STAGE(PG8_SB(0, 0), cB, voffB); PG8_STAGE(PG8_SB(0, 1), cB + hstep, voffB); PG8_STAGE(PG8_SA(0, 0), cA, voffA); PG8_STAGE(PG8_SA(0, 1), cA + hstep, voffA);
        if (wr == 1) PG8_BAR;
        PG8_WAIT_V(2); PG8_BAR;
        PG8_STAGE(PG8_SB(1, 0), cB + kstep, voffB); PG8_STAGE(PG8_SA(1, 0), cA + kstep, voffA); PG8_STAGE(PG8_SB(1, 1), cB + hstep + kstep, voffB);
        PG8_WAIT_V(6); PG8_BAR;
    } else {
        PG8_STAGE(PG8_SB(0, 0), cB, voffB); PG8_STAGE(PG8_SA(0, 0), cA, voffA); PG8_STAGE(PG8_SB(0, 1), cB + hstep, voffB); PG8_STAGE(PG8_SA(0, 1), cA + hstep, voffA);
        if (wr == 1) PG8_BAR;
        PG8_WAIT_V(4); PG8_BAR;
        PG8_STAGE(PG8_SB(1, 0), cB + kstep, voffB); PG8_STAGE(PG8_SA(1, 0), cA + kstep, voffA); PG8_STAGE(PG8_SB(1, 1), cB + hstep + kstep, voffB);
        PG8_WAIT_V(6); PG8_BAR;
    }
    for (;;) {
        const bool has_next = S.next(ui + 1, nxt);
        const char* nA = has_next ? (const char*)g.A + S.a_off(nxt, K) : cA; const char* nB = has_next ? (const char*)g.Bt + S.b_off(nxt, K) : cB;
        for (int t = 0; t < nt; t += 2) {
            const bool last = (t == nt - 2);
            const char* a1 = cA + (size_t)(t + 1) * kstep;
            const char* a2 = last ? nA : cA + (size_t)(t + 2) * kstep; const char* b2 = last ? nB : cB + (size_t)(t + 2) * kstep;
            const char* a3 = a2 + kstep; const char* b3 = b2 + kstep;
            if (last && has_next) S.a_ready(nxt);
            if constexpr (SP2) {
            PG8_LDB(B0, 0, 0); PG8_LDB(B1, 0, 1); PG8_SCHED; PG8_LDA(At, 0, 0); PG8_STAGE(PG8_SA(1, 1), a1 + hstep, voffA);
            PG8_WAIT_V(8); PG8_WAIT_L(0); PG8_BAR; PG8_MMA(0, 0, At, B0); PG8_MMA(0, 1, At, B1); PG8_BAR; PG8_SCHED;
            PG8_LDA(At, 0, 1); PG8_STAGE(PG8_SB(0, 0), b2, voffB); PG8_STAGE(PG8_SB(0, 1), b2 + hstep, voffB); PG8_STAGE(PG8_SA(0, 0), a2, voffA);
            PG8_WAIT_V(8); PG8_WAIT_L(0); PG8_BAR; PG8_MMA(1, 0, At, B0); PG8_MMA(1, 1, At, B1); PG8_BAR; PG8_SCHED;
            PG8_LDB(B0, 1, 0); PG8_LDB(B1, 1, 1); PG8_SCHED; PG8_LDA(At, 1, 0); PG8_STAGE(PG8_SA(0, 1), a2 + hstep, voffA);
            PG8_WAIT_V(8); PG8_WAIT_L(0); PG8_BAR; PG8_MMA(0, 0, At, B0); PG8_MMA(0, 1, At, B1); PG8_BAR; PG8_SCHED;
            PG8_LDA(At, 1, 1); PG8_STAGE(PG8_SB(1, 0), b3, voffB); PG8_STAGE(PG8_SB(1, 1), b3 + hstep, voffB); PG8_STAGE(PG8_SA(1, 0), a3, voffA);
            PG8_WAIT_V(8); PG8_WAIT_L(0); PG8_BAR; PG8_MMA(1, 0, At, B0); PG8_MMA(1, 1, At, B1); PG8_BAR; PG8_SCHED;
            } else {
            PG8_LDB(B0, 0, 0); PG8_SCHED; PG8_LDA(At, 0, 0); PG8_STAGE(PG8_SA(1, 1), a1 + hstep, voffA);
            PG8_WAIT_L(8); PG8_BAR; PG8_WAIT_L(0); PG8_MMA(0, 0, At, B0); PG8_BAR; PG8_SCHED;
            PG8_LDB(B1, 0, 1); PG8_STAGE(PG8_SB(0, 0), b2, voffB);
            PG8_BAR; PG8_WAIT_L(0); PG8_MMA(0, 1, At, B1); PG8_BAR;
            PG8_LDA(At, 0, 1); PG8_STAGE(PG8_SA(0, 0), a2, voffA);
            PG8_BAR; PG8_WAIT_L(0); PG8_MMA(1, 0, At, B0); PG8_BAR; PG8_SCHED;
            PG8_STAGE(PG8_SB(0, 1), b2 + hstep, voffB);
            PG8_WAIT_V(6); PG8_BAR; PG8_MMA(1, 1, At, B1); PG8_BAR;
            PG8_LDB(B0, 1, 0); PG8_SCHED; PG8_LDA(At, 1, 0); PG8_STAGE(PG8_SA(0, 1), a2 + hstep, voffA);
            PG8_WAIT_L(8); PG8_BAR; PG8_WAIT_L(0); PG8_MMA(0, 0, At, B0); PG8_BAR; PG8_SCHED;
            PG8_LDB(B1, 1, 1); PG8_STAGE(PG8_SB(1, 0), b3, voffB);
            PG8_BAR; PG8_WAIT_L(0); PG8_MMA(0, 1, At, B1); PG8_BAR;
            PG8_LDA(At, 1, 1); PG8_STAGE(PG8_SA(1, 0), a3, voffA);
            PG8_BAR; PG8_WAIT_L(0); PG8_MMA(1, 0, At, B0); PG8_BAR; PG8_SCHED;
            PG8_STAGE(PG8_SB(1, 1), b3 + hstep, voffB);
            PG8_WAIT_V(6); PG8_BAR; PG8_MMA(1, 1, At, B1); PG8_BAR;
            }
        }
        if constexpr (ALIGN_EPI) { if (wr == 0) PG8_BAR; }
        if constexpr (!Epi::AFTER_DRAIN) { E(acc, cur, wr, wc, fr, fq); S.done(cur); }
        if (!has_next) break;
#pragma unroll
        for (int a = 0; a < 2; ++a)
#pragma unroll
            for (int b = 0; b < 2; ++b)
#pragma unroll
                for (int m = 0; m < 4; ++m)
#pragma unroll
                    for (int n = 0; n < 2; ++n) acc[a][b][m][n] = (f32x4){0.f, 0.f, 0.f, 0.f};
        cur = nxt; cA = nA; cB = nB; ++ui;
        if constexpr (ALIGN_EPI) { if (wr == 1) PG8_BAR; }
    }
    PG8_WAIT_V(0);
    if constexpr (!ALIGN_EPI) { if (wr == 0) PG8_BAR; }
    PG8_BAR;
    if constexpr (Epi::AFTER_DRAIN) { E.fused(acc, cur, wr, wc, fr, fq, lds, wid, lane); S.done(cur); }
#undef PG8_SA
#undef PG8_SB
#undef PG8_STAGE
#undef PG8_LDA
#undef PG8_LDB
#undef PG8_MMA
#undef PG8_WAIT_V
#undef PG8_WAIT_L
#undef PG8_BAR
#undef PG8_SCHED
}
}

typedef unsigned short bf16;
typedef short bf16x8 __attribute__((ext_vector_type(8)));
typedef float f32x4 __attribute__((ext_vector_type(4)));
typedef float f32x16 __attribute__((ext_vector_type(16)));
typedef unsigned u32x4 __attribute__((ext_vector_type(4)));
typedef unsigned u32x2 __attribute__((ext_vector_type(2)));
typedef float f32x2_t __attribute__((ext_vector_type(2)));
typedef __bf16 bf16x2_t __attribute__((ext_vector_type(2)));
#define LAS __attribute__((address_space(3)))

constexpr int DM = 1024, NTOK = 16384, NPR = 8192, DFF = 2816, NKV = NTOK + 2048;
constexpr float EPS = 1e-6f, LOG2E = 1.4426950408889634f;
constexpr size_t MiB = 1u << 20;
constexpr size_t OUT_Y = 0, OUT_LAT = 16777216, OUT_NA = OUT_LAT + 4718592, OUT_SW = OUT_NA + 16777216;
constexpr size_t WS_MODS = 0;
constexpr size_t WS_TAB8 = 1 * MiB;
constexpr size_t WS_TAB16 = 1 * MiB + 65536;
constexpr size_t WS_BAR = 1 * MiB + 262144;
constexpr size_t WS_MODP = 2 * MiB;
constexpr size_t WS_WIN_E = 10 * MiB, WS_WUQ = 14 * MiB, WS_WUK = 16 * MiB, WS_WUV = 17 * MiB, WS_WOUT_E = 18 * MiB;
constexpr size_t WS_WIN_O = 22 * MiB, WS_WV_O = 31 * MiB, WS_WOUT_O = 34 * MiB, WS_WUP = 38 * MiB, WS_WDOWN = 82 * MiB;
constexpr size_t WS_KC_NA = 104 * MiB, WS_VTC_NA = 108 * MiB, WS_KC_SW = 112 * MiB, WS_VTC_SW = 113 * MiB;
constexpr size_t WS_X = 114 * MiB, WS_HN = 178 * MiB, WS_S = 210 * MiB;
constexpr size_t WS_Z = WS_S, WS_QF = WS_S, WS_KNOPE = WS_S + 40 * MiB, WS_VT = WS_S + 67 * MiB, WS_QAN = WS_S + 94 * MiB,
                 WS_LATN = WS_S + 106 * MiB, WS_KR = WS_S + 115 * MiB, WS_MIX = WS_S + 117 * MiB;
constexpr size_t WS_VT_O = WS_S + 72 * MiB;
constexpr size_t WS_ACT = WS_S;
constexpr size_t WS_END = WS_S + 149 * MiB;
constexpr int LDS_BYTES = 147456;

#ifndef ATT_REP
#define ATT_REP 1
#endif
#ifndef PRO_REP
#define PRO_REP 1
#endif
#ifndef SIDE_REP
#define SIDE_REP 1
#endif
#ifndef GEMM_REP
#define GEMM_REP 1
#endif
struct Args { const float* in[28]; float* out; unsigned char* ws; };

__device__ __forceinline__ unsigned pk2(float lo, float hi) { f32x2_t v = {lo, hi}; bf16x2_t b = __builtin_convertvector(v, bf16x2_t); return __builtin_bit_cast(unsigned, b); }
__device__ __forceinline__ float bflo(unsigned u) { return __uint_as_float(u << 16); }
__device__ __forceinline__ float bfhi(unsigned u) { return __uint_as_float(u & 0xffff0000u); }
__device__ __forceinline__ void unpack8(const u32x4 w, float* f) { f[0] = bflo(w.x); f[1] = bfhi(w.x); f[2] = bflo(w.y); f[3] = bfhi(w.y); f[4] = bflo(w.z); f[5] = bfhi(w.z); f[6] = bflo(w.w); f[7] = bfhi(w.w); }
__device__ __forceinline__ u32x4 pack8(const float* f) { u32x4 w; w.x = pk2(f[0], f[1]); w.y = pk2(f[2], f[3]); w.z = pk2(f[4], f[5]); w.w = pk2(f[6], f[7]); return w; }
__device__ __forceinline__ float wave_sum(float v) {
#pragma unroll
    for (int o = 1; o < 64; o <<= 1) v += __shfl_xor(v, o);
    return v;
}
#define LDS_WAIT() asm volatile("s_waitcnt lgkmcnt(0)" ::: "memory")
__device__ __forceinline__ int vec_of_row(int m) { return m < NPR ? 0 : 1 + ((m - NPR) >> 11); }

__device__ __forceinline__ void tr_item(const float* __restrict__ W, int ldw, bf16* __restrict__ WT, int ldt, float* scr, int lane) {
    {
        f32x4 t[8];
#pragma unroll
        for (int i = 0; i < 8; ++i) t[i] = *(const f32x4*)(W + (size_t)(8 * i + (lane >> 3)) * ldw + 4 * (lane & 7));
#pragma unroll
        for (int i = 0; i < 8; ++i) { float* d = scr + (8 * i + (lane >> 3)) * 33 + 4 * (lane & 7); d[0] = t[i].x; d[1] = t[i].y; d[2] = t[i].z; d[3] = t[i].w; }
    }
    LDS_WAIT();
    const int c = lane & 7;
#pragma unroll
    for (int j = 0; j < 4; ++j) { const int n = (lane >> 3) + 8 * j; const float* s = scr + (8 * c) * 33 + n;
        u32x4 o; o.x = pk2(s[0 * 33], s[1 * 33]); o.y = pk2(s[2 * 33], s[3 * 33]); o.z = pk2(s[4 * 33], s[5 * 33]); o.w = pk2(s[6 * 33], s[7 * 33]);
        *(u32x4*)(WT + (size_t)n * ldt + 8 * c) = o; }
    LDS_WAIT();
}
__device__ __forceinline__ void tr_job(int r, const float* src, int ldw, int nblk, int col0, bf16* dst, int ldt, int row0, float* scr, int lane) {
    const int kb = r / nblk, nb = r % nblk;
    tr_item(src + (size_t)(64 * kb) * ldw + col0 + 32 * nb, ldw, dst + (size_t)(row0 + 32 * nb) * ldt + 64 * kb, ldt, scr, lane);
}

struct EpiRes {
    static constexpr bool PERM = false, AFTER_DRAIN = false;
    float* X; const float* gate;
    __device__ __forceinline__ void operator()(const pg8::f32x4 (&acc)[2][2][4][2], const pg8::Unit& u, int wr, int wc, int fr, int fq) const {
        const int rowt = u.pm * 256; const float* gp = gate + (size_t)vec_of_row(rowt) * 6144;
        const int col0 = u.pn * 256 + wc * 32 + 4 * fq;
        f32x4 gv[2][2];
#pragma unroll
        for (int bj = 0; bj < 2; ++bj)
#pragma unroll
            for (int n = 0; n < 2; ++n) gv[bj][n] = *(const f32x4*)(gp + col0 + bj * 128 + n * 16);
#pragma unroll
        for (int ai = 0; ai < 2; ++ai)
#pragma unroll
            for (int m = 0; m < 4; ++m) { float* xr = X + (size_t)(rowt + ai * 128 + wr * 64 + m * 16 + fr) * DM + col0;
#pragma unroll
                for (int bj = 0; bj < 2; ++bj)
#pragma unroll
                    for (int n = 0; n < 2; ++n) { f32x4 x = *(const f32x4*)(xr + bj * 128 + n * 16); x = x + gv[bj][n] * acc[ai][bj][m][n]; *(f32x4*)(xr + bj * 128 + n * 16) = x; } }
    }
};


__device__ __forceinline__ int uprow(int pm) { if (pm < 32) return pm * 256; const int q = pm - 32, b = q / 9, i = q - 9 * b; return NPR + b * 2048 + 254 * i - 1; }
struct UpOrder : pg8::StaticOrder {
    __device__ __forceinline__ size_t a_off(const pg8::Unit& u, int K) const { return (size_t)uprow(u.pm) * K * 2; }
};
struct OddOrder {
    int G, c; size_t a2, b2;
    __device__ __forceinline__ void init(int G_, int c_, size_t a2_, size_t b2_) { G = G_; c = c_; a2 = a2_; b2 = b2_; }
    __device__ __forceinline__ bool next(int i, pg8::Unit& u) const { const int L = i * G + c; if (L >= 768) return false;
        if (L < 576) { u.pm = L & 63; u.pn = L >> 6; } else { const int L2 = L - 576; u.pm = 1000 + (L2 >> 6); u.pn = L2 & 63; }
        return true; }
    __device__ __forceinline__ void a_ready(const pg8::Unit&) const {}
    __device__ __forceinline__ void done(const pg8::Unit&) const {}
    __device__ __forceinline__ size_t a_off(const pg8::Unit& u, int K) const { return u.pm < 1000 ? (size_t)u.pm * 256 * K * 2 : a2 + (size_t)(u.pm - 1000) * 256 * K * 2; }
    __device__ __forceinline__ size_t b_off(const pg8::Unit& u, int K) const { return u.pm < 1000 ? (size_t)u.pn * 256 * K * 2 : b2 + (size_t)u.pn * 256 * K * 2; }
};
struct EpiOdd {
    static constexpr bool PERM = true, AFTER_DRAIN = false;
    pg8::EpiBf16<0> e1, e2;
    __device__ __forceinline__ void operator()(const pg8::f32x4 (&acc)[2][2][4][2], const pg8::Unit& u, int wr, int wc, int fr, int fq) const {
        if (u.pm < 1000) e1(acc, u, wr, wc, fr, fq);
        else { pg8::Unit v = u; v.pm -= 1000; e2(acc, v, wr, wc, fr, fq); }
    }
};
#define DPP_B(SRC, CTRL) __builtin_bit_cast(float, __builtin_amdgcn_mov_dpp(__builtin_bit_cast(int, (float)(SRC)), (CTRL), 0xf, 0xf, true))
#define DPP_F(OLD, SRC, CTRL) __builtin_bit_cast(float, __builtin_amdgcn_update_dpp(__builtin_bit_cast(int, (float)(OLD)), __builtin_bit_cast(int, (float)(SRC)), (CTRL), 0xf, 0xf, false))
struct EpiUpConv {
    static constexpr bool PERM = true, AFTER_DRAIN = false;
    bf16* ACT; const float* cw; const float* cb; float* xch;
    __device__ __forceinline__ void operator()(const pg8::f32x4 (&acc_)[2][2][4][2], const pg8::Unit& u, int wr, int wc, int fr, int fq) const {
        pg8::f32x4 (&A)[2][2][4][2] = const_cast<pg8::f32x4 (&)[2][2][4][2]>(acc_);
        const int pm = u.pm; const bool prompt = pm < 32; const int q = pm - 32, i9 = q - 9 * (q / 9);
        const int pos0 = prompt ? 0 : 254 * i9 - 1, L = prompt ? 256 : 2048, grow0 = uprow(pm);
        const int cbase = 32 * wc + 8 * fq;
        if (!prompt) {
#pragma unroll
            for (int ai = 0; ai < 2; ++ai)
#pragma unroll
                for (int m = 0; m < 4; ++m) { const int pos = pos0 + ai * 128 + wr * 64 + m * 16 + fr; const bool ok = (unsigned)pos < (unsigned)L;
#pragma unroll
                    for (int bj = 0; bj < 2; ++bj)
#pragma unroll
                        for (int n = 0; n < 2; ++n) { if (!ok) A[ai][bj][m][n] = (pg8::f32x4){0.f, 0.f, 0.f, 0.f}; } }
        }
#pragma unroll
        for (int ai = 0; ai < 2; ++ai)
#pragma unroll
            for (int bj = 0; bj < 2; ++bj)
#pragma unroll
                for (int n = 0; n < 2; ++n) {
                    if (fr == 0) *(pg8::f32x4*)(xch + ((0 * 2 + ai) * 2 + wr) * 256 + 128 * bj + cbase + 4 * n) = A[ai][bj][0][n];
                    if (fr == 15) *(pg8::f32x4*)(xch + ((1 * 2 + ai) * 2 + wr) * 256 + 128 * bj + cbase + 4 * n) = A[ai][bj][3][n];
                }
        asm volatile("s_waitcnt lgkmcnt(0)" ::: "memory"); __builtin_amdgcn_s_barrier(); asm volatile("" ::: "memory");
        const int fbase = 128 * u.pn + cbase;
#pragma unroll
        for (int n = 0; n < 2; ++n) {
            asm volatile("" ::: "memory");
            const int f = fbase + 4 * n;
            pg8::f32x4 w[2][3], bb[2];
#pragma unroll
            for (int bj = 0; bj < 2; ++bj) { bb[bj] = *(const pg8::f32x4*)(cb + bj * DFF + f);
#pragma unroll
                for (int t = 0; t < 3; ++t) w[bj][t] = *(const pg8::f32x4*)(cw + t * 2 * DFF + bj * DFF + f); }
#pragma unroll
            for (int ai = 0; ai < 2; ++ai) {
                asm volatile("" ::: "memory");
                pg8::f32x4 ab[2], be[2];
#pragma unroll
                for (int bj = 0; bj < 2; ++bj) {
                    const int co = 128 * bj + cbase + 4 * n;
                    if (wr == 1) ab[bj] = *(const pg8::f32x4*)(xch + ((1 * 2 + ai) * 2 + 0) * 256 + co);
                    else if (ai == 1) ab[bj] = *(const pg8::f32x4*)(xch + ((1 * 2 + 0) * 2 + 1) * 256 + co);
                    else ab[bj] = (pg8::f32x4){0.f, 0.f, 0.f, 0.f};
                    if (wr == 0) be[bj] = *(const pg8::f32x4*)(xch + ((0 * 2 + ai) * 2 + 1) * 256 + co);
                    else if (ai == 0) be[bj] = *(const pg8::f32x4*)(xch + ((0 * 2 + 1) * 2 + 0) * 256 + co);
                    else be[bj] = (pg8::f32x4){0.f, 0.f, 0.f, 0.f};
                }
#pragma unroll
                for (int m = 0; m < 4; ++m) {
                    float cv[2][4];
#pragma unroll
                    for (int bj = 0; bj < 2; ++bj)
#pragma unroll
                        for (int k = 0; k < 4; ++k) {
                            const float cur = A[ai][bj][m][n][k];
                            float up, dn;
                            if (m == 0) up = DPP_F(ab[bj][k], cur, 0x111);
                            else { const float t_ = DPP_B(A[ai][bj][m - 1][n][k], 0x10F); up = DPP_F(t_, cur, 0x111); }
                            if (m == 3) dn = DPP_F(be[bj][k], cur, 0x101);
                            else { const float t_ = DPP_B(A[ai][bj][m + 1][n][k], 0x11F); dn = DPP_F(t_, cur, 0x101); }
                            cv[bj][k] = w[bj][0][k] * up + w[bj][1][k] * cur + w[bj][2][k] * dn + bb[bj][k];
                        }
                    const int r = ai * 128 + wr * 64 + m * 16 + fr;
                    const bool okout = prompt || (r >= 1 && r <= 254 && pos0 + r < 2048);
                    if (okout) {
                        float o[4];
#pragma unroll
                        for (int k = 0; k < 4; ++k) o[k] = cv[0][k] * cv[1][k] * __builtin_amdgcn_rcpf(1.0f + __expf(-cv[1][k]));
                        u32x2 pkd; pkd.x = pk2(o[0], o[1]); pkd.y = pk2(o[2], o[3]);
                        *(u32x2*)(ACT + (size_t)(grow0 + r) * DFF + f) = pkd;
                    }
                }
            }
        }
    }
};

__device__ __forceinline__ void norm_mod_rows(const float* __restrict__ xp, const float* __restrict__ xs, float* __restrict__ Xout, bf16* __restrict__ Hn,
                                              const float* __restrict__ g, const float* __restrict__ modsl, int shift_slot, int gw, int NGW, int lane) {
    for (int m0 = gw; m0 < NTOK / 2; m0 += NGW) {
        f32x4 v[2][4]; float ss[2];
#pragma unroll
        for (int h = 0; h < 2; ++h) { const int m = m0 + h * (NTOK / 2); const float* xr = (m < NPR) ? xp + (size_t)m * DM : xs + (size_t)(m - NPR) * DM; ss[h] = 0.f;
#pragma unroll
            for (int j = 0; j < 4; ++j) v[h][j] = *(const f32x4*)(xr + 4 * (lane + 64 * j)); }
#pragma unroll
        for (int h = 0; h < 2; ++h)
#pragma unroll
            for (int j = 0; j < 4; ++j) ss[h] += (v[h][j].x * v[h][j].x + v[h][j].y * v[h][j].y) + (v[h][j].z * v[h][j].z + v[h][j].w * v[h][j].w);
#pragma unroll
        for (int h = 0; h < 2; ++h) { const int m = m0 + h * (NTOK / 2);
            const float rstd = 1.0f / sqrtf(wave_sum(ss[h]) * (1.0f / DM) + EPS);
            const float* sh = modsl + (size_t)vec_of_row(m) * 6144 + shift_slot * 1024; const float* sc = sh + 1024;
#pragma unroll
            for (int j = 0; j < 4; ++j) { const int col = 4 * (lane + 64 * j);
                const f32x4 gg = *(const f32x4*)(g + col), s4 = *(const f32x4*)(sc + col), h4 = *(const f32x4*)(sh + col);
                const f32x4 hh = v[h][j] * rstd * gg * (s4 + 1.0f) + h4;
                u32x2 w; w.x = pk2(hh.x, hh.y); w.y = pk2(hh.z, hh.w); *(u32x2*)(Hn + (size_t)m * DM + col) = w;
                if (Xout) *(f32x4*)(Xout + (size_t)m * DM + col) = v[h][j]; } }
    }
}
__device__ __forceinline__ void final_norm_rows(const float* __restrict__ X, float* __restrict__ out, const float* __restrict__ g, int gw, int NGW, int lane) {
    for (int m0 = gw; m0 < NTOK / 2; m0 += NGW) {
        f32x4 v[2][4]; float ss[2];
#pragma unroll
        for (int h = 0; h < 2; ++h) { const float* xr = X + (size_t)(m0 + h * (NTOK / 2)) * DM; ss[h] = 0.f;
#pragma unroll
            for (int j = 0; j < 4; ++j) v[h][j] = *(const f32x4*)(xr + 4 * (lane + 64 * j)); }
#pragma unroll
        for (int h = 0; h < 2; ++h)
#pragma unroll
            for (int j = 0; j < 4; ++j) ss[h] += (v[h][j].x * v[h][j].x + v[h][j].y * v[h][j].y) + (v[h][j].z * v[h][j].z + v[h][j].w * v[h][j].w);
#pragma unroll
        for (int h = 0; h < 2; ++h) { const int m = m0 + h * (NTOK / 2); const float rstd = 1.0f / sqrtf(wave_sum(ss[h]) * (1.0f / DM) + EPS);
#pragma unroll
            for (int j = 0; j < 4; ++j) { const int col = 4 * (lane + 64 * j); const f32x4 gg = *(const f32x4*)(g + col); *(f32x4*)(out + (size_t)m * DM + col) = v[h][j] * rstd * gg; } }
    }
}

__device__ __forceinline__ void even_post(const bf16* __restrict__ Z, bf16* __restrict__ QAn, bf16* __restrict__ LATn, bf16* __restrict__ KR, bf16* __restrict__ MIX,
                                          float* __restrict__ out_lat, const float* __restrict__ cache_mla, const float* __restrict__ gq, const float* __restrict__ gkv,
                                          const float* __restrict__ tab8, int e, int gw, int NGW, int lane) {
    for (int m = gw; m < NKV; m += NGW) {
        if (m >= NTOK) {
            const int i = m - NTOK, b = i >> 9, t = i & 511; const float* src = cache_mla + ((size_t)(b * 2 + e) * 512 + t) * 288;
            const f32x4 v = *(const f32x4*)(src + 4 * lane); u32x2 w; w.x = pk2(v.x, v.y); w.y = pk2(v.z, v.w); *(u32x2*)(LATn + (size_t)m * 256 + 4 * lane) = w;
            if (lane < 8) { const f32x4 r = *(const f32x4*)(src + 256 + 4 * lane); u32x2 q; q.x = pk2(r.x, r.y); q.y = pk2(r.z, r.w); *(u32x2*)(KR + (size_t)m * 32 + 4 * lane) = q; }
            continue;
        }
        const bool prompt = m < NPR; const int b = prompt ? (m >> 8) : ((m - NPR) >> 11), t = prompt ? (m & 255) : ((m - NPR) & 2047);
        float f[16];
#pragma unroll
        for (int i = 0; i < 16; ++i) f[i] = 0.f;
        if (lane < 58) { const bf16* zr = Z + (size_t)m * DM + 16 * lane; unpack8(*(const u32x4*)zr, f); unpack8(*(const u32x4*)(zr + 8), f + 8); }
        float ss = 0.f;
#pragma unroll
        for (int i = 0; i < 16; ++i) ss += f[i] * f[i];
        const float ssq = wave_sum(lane < 24 ? ss : 0.f), sskv = wave_sum((lane >= 24 && lane < 40) ? ss : 0.f);
        const float rq = 1.0f / sqrtf(ssq * (1.0f / 384.0f) + EPS), rkv = 1.0f / sqrtf(sskv * (1.0f / 256.0f) + EPS);
        float* olat = out_lat + ((size_t)(b * 2 + e) * 256 + t) * 288;
        if (lane < 24) {
            float o[16];
#pragma unroll
            for (int i = 0; i < 16; ++i) o[i] = f[i] * rq * gq[16 * lane + i];
            bf16* d = QAn + (size_t)m * 384 + 16 * lane; *(u32x4*)d = pack8(o); *(u32x4*)(d + 8) = pack8(o + 8);
        } else if (lane < 40) {
            const int c0 = 16 * (lane - 24); float o[16];
#pragma unroll
            for (int i = 0; i < 16; ++i) o[i] = f[i] * rkv * gkv[c0 + i];
            bf16* d = LATn + (size_t)m * 256 + c0; *(u32x4*)d = pack8(o); *(u32x4*)(d + 8) = pack8(o + 8);
            if (prompt) {
#pragma unroll
                for (int i = 0; i < 4; ++i) *(f32x4*)(olat + c0 + 4 * i) = (f32x4){o[4 * i], o[4 * i + 1], o[4 * i + 2], o[4 * i + 3]};
            }
        } else if (lane < 42) {
            const int half = lane - 40; float o[16];
            if (prompt) {
#pragma unroll
                for (int i = 0; i < 16; ++i) o[i] = f[i];
#pragma unroll
                for (int i = 0; i < 4; ++i) *(f32x4*)(olat + 256 + 16 * half + 4 * i) = (f32x4){o[4 * i], o[4 * i + 1], o[4 * i + 2], o[4 * i + 3]};
            } else {
                const int pos = half == 0 ? (t >> 6) : (t & 63);
#pragma unroll
                for (int i = 0; i < 8; ++i) { const float c = tab8[(pos * 8 + i) * 2], s = tab8[(pos * 8 + i) * 2 + 1]; o[i] = f[i] * c - f[i + 8] * s; o[i + 8] = f[i] * s + f[i + 8] * c; }
            }
            bf16* d = KR + (size_t)m * 32 + 16 * half; *(u32x4*)d = pack8(o); *(u32x4*)(d + 8) = pack8(o + 8);
        }
    }
}

__device__ __forceinline__ void pool_rows(const bf16* __restrict__ Z, bf16* __restrict__ MIX, int gtid, int NGT) {
    for (int idx = gtid; idx < NTOK * 16; idx += NGT) {
        const int m = idx >> 4, cl = idx & 15, g = cl >> 2, hw = 1 << g;
        const bool prompt = m < NPR; const int t = prompt ? (m & 255) : ((m - NPR) & 2047), n = prompt ? 256 : 2048;
        const int lo = (t - hw) > 0 ? (t - hw) : 0, hi = (t + hw) < n ? (t + hw) : n;
        const bf16* zc = Z + (size_t)(m - t) * DM + 672 + 16 * cl;
        float f[16], a[16];
        { const bf16* zr = zc + (size_t)t * DM; unpack8(*(const u32x4*)zr, f); unpack8(*(const u32x4*)(zr + 8), f + 8); }
#pragma unroll
        for (int i = 0; i < 16; ++i) a[i] = 0.f;
#pragma unroll
        for (int bt = 0; bt < 2; ++bt) {
            if (bt * 8 < hi - lo) {
                u32x4 q0[8], q1[8];
#pragma unroll
                for (int j = 0; j < 8; ++j) { int s_ = lo + bt * 8 + j; s_ = s_ < hi ? s_ : hi - 1; const bf16* zr = zc + (size_t)s_ * DM; q0[j] = *(const u32x4*)zr; q1[j] = *(const u32x4*)(zr + 8); }
#pragma unroll
                for (int j = 0; j < 8; ++j) { const float wv = (lo + bt * 8 + j) < hi ? 1.0f : 0.0f; float q[16]; unpack8(q0[j], q); unpack8(q1[j], q + 8);
#pragma unroll
                    for (int i = 0; i < 16; ++i) a[i] += wv * q[i]; }
            }
        }
        const float inv = 1.0f / (float)(hi - lo);
#pragma unroll
        for (int i = 0; i < 16; ++i) a[i] = a[i] * inv - f[i];
        bf16* d = MIX + (size_t)m * DM + 768 + 16 * cl; *(u32x4*)d = pack8(a); *(u32x4*)(d + 8) = pack8(a + 8);
    }
}

__device__ __forceinline__ void odd_post(bf16* __restrict__ Z, float* __restrict__ out_na, float* __restrict__ out_sw, const float* __restrict__ tab16, int e, int gw, int NGW, int lane) {
    for (int m = gw; m < NTOK; m += NGW) {
        bf16* zr = Z + (size_t)m * 2304;
        if (m < NPR) {
            const int b = m >> 8, t = m & 255; float f[16];
            { unpack8(*(const u32x4*)(zr + 512 + 16 * lane), f); unpack8(*(const u32x4*)(zr + 512 + 16 * lane + 8), f + 8);
              float* o = out_na + ((size_t)(b * 2 + e) * 256 + t) * 1024 + 16 * lane;
#pragma unroll
              for (int i = 0; i < 4; ++i) *(f32x4*)(o + 4 * i) = (f32x4){f[4 * i], f[4 * i + 1], f[4 * i + 2], f[4 * i + 3]}; }
            if (lane < 16) { unpack8(*(const u32x4*)(zr + 2048 + 16 * lane), f); unpack8(*(const u32x4*)(zr + 2048 + 16 * lane + 8), f + 8);
              float* o = out_sw + ((size_t)(b * 2 + e) * 256 + t) * 256 + 16 * lane;
#pragma unroll
              for (int i = 0; i < 4; ++i) *(f32x4*)(o + 4 * i) = (f32x4){f[4 * i], f[4 * i + 1], f[4 * i + 2], f[4 * i + 3]}; }
        } else if (lane < 4) {
            const int t = (m - NPR) & 2047, half = lane & 1, pos = half == 0 ? (t >> 6) : (t & 63);
            bf16* p = zr + 2048 + 32 * lane; float f[32], o[32];
#pragma unroll
            for (int i = 0; i < 4; ++i) unpack8(*(const u32x4*)(p + 8 * i), f + 8 * i);
#pragma unroll
            for (int i = 0; i < 16; ++i) { const float c = tab16[(pos * 16 + i) * 2], s = tab16[(pos * 16 + i) * 2 + 1]; o[i] = f[i] * c - f[i + 16] * s; o[i + 16] = f[i] * s + f[i + 16] * c; }
#pragma unroll
            for (int i = 0; i < 4; ++i) *(u32x4*)(p + 8 * i) = pack8(o + 8 * i);
        }
    }
}

template <int MODE>
__device__ __forceinline__ void mask_scale(f32x16& s, int kb  , int qpos, float scale, float sl2, const float* __restrict__ rpb, float& mx) {
#pragma unroll
    for (int r = 0; r < 16; ++r) {
        float v;
        if constexpr (MODE == 0) { v = s[r]; }
        else {
            const int kpos = kb + 16 * (r >> 3) + (r & 7);
            if constexpr (MODE == 1) {
                const int krow = kpos >> 6, kcol = kpos & 63, qrow = qpos >> 6, qcol = qpos & 63;
                int qcs = qcol - 8; qcs = qcs < 0 ? 0 : (qcs > 48 ? 48 : qcs);
                const bool valid = (kcol >= qcs) && (kcol < qcs + 16);
                int dc = kcol - qcol + 15; dc = dc < 0 ? 0 : (dc > 30 ? 30 : dc);
                int dr = krow - qrow + 7; dr = dr < 0 ? 0 : (dr > 14 ? 14 : dr);
                const float bias = rpb[dr * 31 + dc];
                const bool rowok = (krow - qrow + 7 >= 0) && (krow - qrow + 7 <= 14);
                v = (valid && rowok) ? (s[r] * scale + bias) * LOG2E : -INFINITY;
            } else {
                const int d = qpos - kpos; const bool valid = (d <= 128) && (d >= -128);
                v = valid ? s[r] * sl2 : -INFINITY;
            }
        }
        s[r] = v; mx = fmaxf(mx, v);
    }
}

template <int DQ, int MODE  , bool ROPE, bool MLA>
__device__ __forceinline__ void attn_block(
    const bf16* __restrict__ Qp, int qld, int qpos0,
    const bf16* __restrict__ K0, int k0ld, const bf16* __restrict__ K0r, const bf16* __restrict__ V0t, int v0ld, int s0row, int s0nt, int s0pos,
    const bf16* __restrict__ K1, int k1ld, const bf16* __restrict__ K1r, const bf16* __restrict__ V1t, int v1ld, int s1row, int s1nt,
    int my_lo, int my_hi, int na_r0  ,
    float scale, bool has_sink, float sink, const float* __restrict__ rpb, const float* __restrict__ tab,
    bf16* __restrict__ Op, int old, unsigned char* ldsb, int wave, int tid_in)
{
    int tid = tid_in; asm volatile("" : "+v"(tid));
    constexpr int NC = DQ / 16, QLD = DQ + 8, HALF = DQ / 2, KRS = DQ * 2 + 16, VRS = 144, KBUF = 64 * KRS, VBUF = 64 * VRS, STG = KBUF + VBUF;
    const int lane = tid & 63, r32 = lane & 31, hi = lane >> 5;
    bf16* qs = (bf16*)(ldsb + wave * 6656);
    unsigned char* kv = ldsb + 53248;
    {
        const bf16* src = Qp + (size_t)r32 * qld + hi * HALF;
        float f[HALF];
#pragma unroll
        for (int i = 0; i < HALF / 8; ++i) unpack8(*(const u32x4*)(src + 8 * i), f + 8 * i);
        if constexpr (ROPE) {
            const int qp_ = qpos0 + r32;
            if constexpr (MLA) {
                if (hi == 1) {
                    const int pr_ = qp_ >> 6, pc_ = qp_ & 63;
#pragma unroll
                    for (int i = 0; i < 8; ++i) {
                        const float c = tab[(pr_ * 8 + i) * 2], s = tab[(pr_ * 8 + i) * 2 + 1]; const float x1 = f[16 + i], x2 = f[24 + i]; f[16 + i] = x1 * c - x2 * s; f[24 + i] = x1 * s + x2 * c;
                        const float c2 = tab[(pc_ * 8 + i) * 2], s2 = tab[(pc_ * 8 + i) * 2 + 1]; const float y1 = f[32 + i], y2 = f[40 + i]; f[32 + i] = y1 * c2 - y2 * s2; f[40 + i] = y1 * s2 + y2 * c2;
                    }
                }
            } else {
                const int pos = hi == 0 ? (qp_ >> 6) : (qp_ & 63);
#pragma unroll
                for (int i = 0; i < 16; ++i) { const float c = tab[(pos * 16 + i) * 2], s = tab[(pos * 16 + i) * 2 + 1]; const float x1 = f[i], x2 = f[16 + i]; f[i] = x1 * c - x2 * s; f[16 + i] = x1 * s + x2 * c; }
            }
        }
#pragma unroll
        for (int i = 0; i < HALF / 8; ++i) *(u32x4*)(qs + r32 * QLD + hi * HALF + 8 * i) = pack8(f + 8 * i);
    }
    LDS_WAIT();
    bf16x8 qf[NC];
#pragma unroll
    for (int c = 0; c < NC; ++c) qf[c] = *(const bf16x8*)(qs + r32 * QLD + 16 * c + 8 * hi);
    LDS_WAIT();
    const int pr = (r32 & ~12) | ((r32 & 4) << 1) | ((r32 & 8) >> 1);
    f32x16 o0, o1;
#pragma unroll
    for (int r = 0; r < 16; ++r) { o0[r] = 0.f; o1[r] = 0.f; }
    float mrun = -1e30f, lrun = 0.f;
    const int nt = s0nt + s1nt;
    const float sl2 = scale * LOG2E;
    const int qpos = qpos0 + r32;
    const int lrow = tid >> 3, lch = tid & 7;
    u32x4 gk, gr, gv;
    gr = (u32x4){0, 0, 0, 0};
#define AB_GLOAD(T, GK, GR, GV) do { const int t_ = (T); const bool in1_ = t_ >= s0nt; const int tt_ = in1_ ? t_ - s0nt : t_; const int krow_ = (in1_ ? s1row : s0row) + 64 * tt_; \
        GK = *(const u32x4*)((in1_ ? K1 : K0) + (size_t)(krow_ + lrow) * (in1_ ? k1ld : k0ld) + 8 * lch); \
        if constexpr (MLA) { if (tid < 256) GR = *(const u32x4*)((in1_ ? K1r : K0r) + (size_t)(krow_ + (tid >> 2)) * 32 + 8 * (tid & 3)); } \
        GV = *(const u32x4*)((in1_ ? V1t : V0t) + (size_t)lrow * (in1_ ? v1ld : v0ld) + krow_ + 8 * lch); } while (0)
#define AB_LSTORE(B, GK, GR, GV) do { unsigned char* kb_ = kv + (B) * STG; *(u32x4*)(kb_ + lrow * KRS + 16 * lch) = GK; \
        if constexpr (MLA) { if (tid < 256) *(u32x4*)(kb_ + (tid >> 2) * KRS + 128 + 16 * (tid & 3)) = GR; } \
        *(u32x4*)(kb_ + KBUF + lrow * VRS + 16 * lch) = GV; } while (0)
#define AB_ACT(T) ((MODE == 0) || ((T) >= s0nt) || ((T) >= my_lo && (T) <= my_hi))
#define AB_QK(T, SA, SB) do { const unsigned char* kq_ = kv + ((T) % 3) * STG; \
        bf16x8 kfr_[2 * NC];     \
        _Pragma("unroll") for (int c = 0; c < NC; ++c) { \
            kfr_[2 * c] = *(const bf16x8*)(kq_ + pr * KRS + (16 * c + 8 * hi) * 2); \
            kfr_[2 * c + 1] = *(const bf16x8*)(kq_ + (32 + pr) * KRS + (16 * c + 8 * hi) * 2); } \
        asm volatile("s_waitcnt lgkmcnt(0)" ::: "memory"); \
        _Pragma("unroll") for (int r = 0; r < 16; ++r) { SA[r] = 0.f; SB[r] = 0.f; } \
        _Pragma("unroll") for (int c = 0; c < NC; ++c) { \
            SA = __builtin_amdgcn_mfma_f32_32x32x16_bf16(kfr_[2 * c], qf[c], SA, 0, 0, 0); \
            SB = __builtin_amdgcn_mfma_f32_32x32x16_bf16(kfr_[2 * c + 1], qf[c], SB, 0, 0, 0); } } while (0)
#define AB_STEP(T, SA, SB, NA_, NB_, GK, GR, GV) do { const int t = (T); \
        if (t + 2 < nt) AB_LSTORE((t + 2) % 3, GK, GR, GV); \
        if (t + 3 < nt) AB_GLOAD(t + 3, GK, GR, GV); \
        if (t + 1 < nt && AB_ACT(t + 1)) AB_QK(t + 1, NA_, NB_); \
        if (AB_ACT(t)) { \
            const unsigned char* vb = kv + (t % 3) * STG + KBUF; \
            const unsigned char* va = vb + r32 * VRS + 16 * hi; const unsigned char* vc = va + 32 * VRS; \
            bf16x8 vfr_[8];     \
            _Pragma("unroll") for (int j = 0; j < 4; ++j) { vfr_[2 * j] = *(const bf16x8*)(va + 32 * j); vfr_[2 * j + 1] = *(const bf16x8*)(vc + 32 * j); } \
            float mx = -INFINITY, mulf; \
            if (MODE != 0 && t < s0nt) { const int kb0 = s0pos + 64 * t + 8 * hi; \
                mask_scale<MODE>(SA, kb0, qpos, scale, sl2, rpb, mx); mask_scale<MODE>(SB, kb0 + 32, qpos, scale, sl2, rpb, mx); mulf = 1.0f; } \
            else { mask_scale<0>(SA, 0, qpos, scale, sl2, rpb, mx); mask_scale<0>(SB, 0, qpos, scale, sl2, rpb, mx); mx *= sl2; mulf = sl2; } \
            mx = fmaxf(mx, __shfl_xor(mx, 32)); \
            const float mnew = fmaxf(mrun, mx), alpha = __builtin_amdgcn_exp2f(mrun - mnew); mrun = mnew; \
            float ps = 0.f; \
            _Pragma("unroll") for (int r = 0; r < 16; ++r) { const float p = __builtin_amdgcn_exp2f(__builtin_fmaf(SA[r], mulf, -mnew)); SA[r] = p; ps += p; } \
            _Pragma("unroll") for (int r = 0; r < 16; ++r) { const float p = __builtin_amdgcn_exp2f(__builtin_fmaf(SB[r], mulf, -mnew)); SB[r] = p; ps += p; } \
            lrun = lrun * alpha + ps; \
            if (__any(alpha != 1.0f)) { _Pragma("unroll") for (int r = 0; r < 16; ++r) { o0[r] *= alpha; o1[r] *= alpha; } } \
            u32x4 w0, w1, w2, w3; \
            w0.x = pk2(SA[0], SA[1]); w0.y = pk2(SA[2], SA[3]); w0.z = pk2(SA[4], SA[5]); w0.w = pk2(SA[6], SA[7]); \
            w1.x = pk2(SA[8], SA[9]); w1.y = pk2(SA[10], SA[11]); w1.z = pk2(SA[12], SA[13]); w1.w = pk2(SA[14], SA[15]); \
            w2.x = pk2(SB[0], SB[1]); w2.y = pk2(SB[2], SB[3]); w2.z = pk2(SB[4], SB[5]); w2.w = pk2(SB[6], SB[7]); \
            w3.x = pk2(SB[8], SB[9]); w3.y = pk2(SB[10], SB[11]); w3.z = pk2(SB[12], SB[13]); w3.w = pk2(SB[14], SB[15]); \
            const bf16x8 p0 = __builtin_bit_cast(bf16x8, w0), p1 = __builtin_bit_cast(bf16x8, w1), p2 = __builtin_bit_cast(bf16x8, w2), p3 = __builtin_bit_cast(bf16x8, w3); \
            o0 = __builtin_amdgcn_mfma_f32_32x32x16_bf16(vfr_[0], p0, o0, 0, 0, 0); \
            o1 = __builtin_amdgcn_mfma_f32_32x32x16_bf16(vfr_[1], p0, o1, 0, 0, 0); \
            o0 = __builtin_amdgcn_mfma_f32_32x32x16_bf16(vfr_[2], p1, o0, 0, 0, 0); \
            o1 = __builtin_amdgcn_mfma_f32_32x32x16_bf16(vfr_[3], p1, o1, 0, 0, 0); \
            o0 = __builtin_amdgcn_mfma_f32_32x32x16_bf16(vfr_[4], p2, o0, 0, 0, 0); \
            o1 = __builtin_amdgcn_mfma_f32_32x32x16_bf16(vfr_[5], p2, o1, 0, 0, 0); \
            o0 = __builtin_amdgcn_mfma_f32_32x32x16_bf16(vfr_[6], p3, o0, 0, 0, 0); \
            o1 = __builtin_amdgcn_mfma_f32_32x32x16_bf16(vfr_[7], p3, o1, 0, 0, 0); \
        } \
        asm volatile("s_waitcnt lgkmcnt(0)\n\ts_barrier" ::: "memory"); } while (0)
    f32x16 sA, sB, sC, sD;
    AB_GLOAD(0, gk, gr, gv); AB_LSTORE(0, gk, gr, gv);
    if (nt > 1) { AB_GLOAD(1, gk, gr, gv); AB_LSTORE(1, gk, gr, gv); }
    if (nt > 2) AB_GLOAD(2, gk, gr, gv);
    asm volatile("s_waitcnt lgkmcnt(0)\n\ts_barrier" ::: "memory");
    if (AB_ACT(0)) AB_QK(0, sA, sB);
    for (int tt = 0; tt < nt; tt += 2) {
        AB_STEP(tt, sA, sB, sC, sD, gk, gr, gv);
        if (tt + 1 < nt) AB_STEP(tt + 1, sC, sD, sA, sB, gk, gr, gv);
    }
#undef AB_STEP
#undef AB_QK
#undef AB_ACT
#undef AB_GLOAD
#undef AB_LSTORE
    lrun += __shfl_xor(lrun, 32);
    if (has_sink) lrun += __builtin_amdgcn_exp2f(sink * LOG2E - mrun);
    const float inv = 1.0f / lrun;
    bf16* op = Op + (size_t)r32 * old + 4 * hi;
#pragma unroll
    for (int g = 0; g < 4; ++g) {
        u32x2 a; a.x = pk2(o0[4 * g] * inv, o0[4 * g + 1] * inv); a.y = pk2(o0[4 * g + 2] * inv, o0[4 * g + 3] * inv); *(u32x2*)(op + 8 * g) = a;
        u32x2 b; b.x = pk2(o1[4 * g] * inv, o1[4 * g + 1] * inv); b.y = pk2(o1[4 * g + 2] * inv, o1[4 * g + 3] * inv); *(u32x2*)(op + 32 + 8 * g) = b;
    }
}


#define XB_TMO      128
#define XB_XCNT(j)  (256  + 64 * (j))
#define XB_XSUB(j)  (1280 + 64 * (j))
#define XB_XGEN(j)  (2304 + 64 * (j))
#define XB_TOP      3328
#define XB_TOPGEN   3392
#define XCD_BAR_WORDS 3456
#define XB_SPIN_CAP (1u << 18)

__device__ __forceinline__ unsigned xb_ld(unsigned* p)              { return __hip_atomic_load(p, __ATOMIC_RELAXED, __HIP_MEMORY_SCOPE_AGENT); }
__device__ __forceinline__ unsigned xb_add(unsigned* p, unsigned v) { return __hip_atomic_fetch_add(p, v, __ATOMIC_RELAXED, __HIP_MEMORY_SCOPE_AGENT); }
__device__ __forceinline__ unsigned xb_xcc_id() { return (unsigned)__builtin_amdgcn_s_getreg((3 << 11) | 20) & 0xFu; }
#define XB_SPIN(cond, bar) do { unsigned _sp = 0; while (cond) { __builtin_amdgcn_s_sleep(1); \
    if ((++_sp & 255u) == 0u) { if (xb_ld(&(bar)[XB_TMO])) break; if (_sp > XB_SPIN_CAP) { atomicAdd(&(bar)[XB_TMO], 1u); break; } } } } while (0)

struct XcdBarrier {
    unsigned* bar; unsigned x;
    volatile LAS unsigned* st;
};

__device__ __forceinline__ XcdBarrier xcd_barrier_post(unsigned* bar, volatile LAS unsigned* st) {
    XcdBarrier b; b.bar = bar; b.x = xb_xcc_id(); b.st = st;
    if (threadIdx.x == 0) (void)xb_add(&bar[XB_XCNT(b.x)], 1u);
    return b;
}
__device__ __forceinline__ void xcd_barrier_complete(unsigned* bar, unsigned x, unsigned& nloc, unsigned& nx) {
    const unsigned G = gridDim.x * gridDim.y * gridDim.z;
    unsigned sum, cnt, mine, sp = 0u;
    for (;;) {
        sum = 0u; cnt = 0u; mine = 0u;
#pragma nounroll
        for (unsigned j = 0; j < 16; ++j) { const unsigned c = xb_ld(&bar[XB_XCNT(j)]); sum += c; cnt += (c > 0u) ? 1u : 0u; mine = (j == x) ? c : mine; }
        if (sum == G) break;
        __builtin_amdgcn_s_sleep(1);
        if ((++sp & 255u) == 0u) { if (xb_ld(&bar[XB_TMO])) break; if (sp > XB_SPIN_CAP) { atomicAdd(&bar[XB_TMO], 1u); break; } }
    }
    nloc = mine > 0u ? mine : 1u; nx = cnt > 0u ? cnt : 1u;
}

__device__ __forceinline__ void xcd_barrier(const XcdBarrier& b) {
    asm volatile("s_waitcnt vmcnt(0)" ::: "memory");
    __syncthreads();
    if (threadIdx.x == 0) {
        unsigned* bar = b.bar; const unsigned bx = (unsigned)__builtin_amdgcn_readfirstlane((int)xb_xcc_id());
        __builtin_amdgcn_s_waitcnt(0);
        unsigned nloc = b.st[0], nx = b.st[1];
        if (nloc == 0u) { xcd_barrier_complete(bar, bx, nloc, nx); b.st[0] = nloc; b.st[1] = nx; }
        const unsigned old = xb_add(&bar[XB_XSUB(bx)], 1u);
        const unsigned gen = old / nloc;
        if (old + 1u == (gen + 1u) * nloc) {
            __builtin_amdgcn_fence(__ATOMIC_RELEASE, "agent");
            asm volatile("s_waitcnt vmcnt(0)" ::: "memory");
            const unsigned og = xb_add(&bar[XB_TOP], 1u);
            const unsigned tg = og / nx;
            if (og + 1u == (tg + 1u) * nx) xb_add(&bar[XB_TOPGEN], 1u);
            else XB_SPIN(xb_ld(&bar[XB_TOPGEN]) == tg, bar);
            __builtin_amdgcn_fence(__ATOMIC_ACQUIRE, "agent");
            xb_add(&bar[XB_XGEN(bx)], 1u);
            asm volatile("s_waitcnt vmcnt(0)" ::: "memory");
        } else {
            XB_SPIN(xb_ld(&bar[XB_XGEN(bx)]) == gen, bar);
            __builtin_amdgcn_fence(__ATOMIC_ACQUIRE, "agent");
            asm volatile("s_waitcnt vmcnt(0)" ::: "memory");
        }
    }
    __syncthreads();
}

#define GEMM_BF16(Aptr, Bptr, Mv, Nv, Kv, Optr, LDC) do { \
    pg8::Gemm g_{(const pg8::bf16_t*)(Aptr), (const pg8::bf16_t*)(Bptr), (Mv), (Nv), (Kv)}; pg8::StaticOrder S_; S_.init((Mv), (Nv), G, (int)blockIdx.x); \
    pg8::EpiBf16<0> E_{(pg8::bf16_t*)(Optr), (LDC), nullptr, 0, 0, 1.f}; \
    for (int rep_ = 0; rep_ < GEMM_REP; ++rep_) pg8::gemm_phase<pg8::EpiBf16<0>, pg8::StaticOrder, true, true>(ldsg, g_, S_, E_); } while (0)
#define GEMM_RES(Aptr, Bptr, Kv, GATE) do { \
    pg8::Gemm g_{(const pg8::bf16_t*)(Aptr), (const pg8::bf16_t*)(Bptr), NTOK, DM, (Kv)}; pg8::StaticOrder S_; S_.init(NTOK, DM, G, (int)blockIdx.x); \
    EpiRes E_{X, (GATE)}; \
    pg8::gemm_phase<EpiRes, pg8::StaticOrder, true, true>(ldsg, g_, S_, E_); } while (0)

__global__ void __launch_bounds__(512) fwd_kernel(Args a) {
    extern __shared__ __attribute__((aligned(16))) unsigned char lds[];
    cg::grid_group grid = cg::this_grid();
    PG8_LAS unsigned char* ldsg = (PG8_LAS unsigned char*)lds;
    const int wave = __builtin_amdgcn_readfirstlane((int)threadIdx.x >> 6);
    const int G = gridDim.x, gw = blockIdx.x * 8 + wave, NGW = G * 8, NGT = G * 512;
#define FRESH() int tid = threadIdx.x; asm volatile("" : "+v"(tid)); const int lane = tid & 63, gtid = blockIdx.x * 512 + tid; (void)lane; (void)gtid
    unsigned char* ws = a.ws;
    float* mods = (float*)(ws + WS_MODS); float* tab8 = (float*)(ws + WS_TAB8); float* tab16 = (float*)(ws + WS_TAB16); float* modp = (float*)(ws + WS_MODP);
    bf16* WIN_E = (bf16*)(ws + WS_WIN_E); bf16* WUQ = (bf16*)(ws + WS_WUQ); bf16* WUK = (bf16*)(ws + WS_WUK); bf16* WUV = (bf16*)(ws + WS_WUV); bf16* WOUT_E = (bf16*)(ws + WS_WOUT_E);
    bf16* WIN_O = (bf16*)(ws + WS_WIN_O); bf16* WV_O = (bf16*)(ws + WS_WV_O); bf16* WOUT_O = (bf16*)(ws + WS_WOUT_O); bf16* WUP = (bf16*)(ws + WS_WUP); bf16* WDOWN = (bf16*)(ws + WS_WDOWN);
    bf16* KC_NA = (bf16*)(ws + WS_KC_NA); bf16* VTC_NA = (bf16*)(ws + WS_VTC_NA); bf16* KC_SW = (bf16*)(ws + WS_KC_SW); bf16* VTC_SW = (bf16*)(ws + WS_VTC_SW);
    float* X = (float*)(ws + WS_X); bf16* HN = (bf16*)(ws + WS_HN);
    bf16* Z = (bf16*)(ws + WS_Z); bf16* QF = (bf16*)(ws + WS_QF); bf16* KNOPE = (bf16*)(ws + WS_KNOPE); bf16* VT = (bf16*)(ws + WS_VT); bf16* QAN = (bf16*)(ws + WS_QAN);
    bf16* LATN = (bf16*)(ws + WS_LATN); bf16* KR = (bf16*)(ws + WS_KR); bf16* MIX = (bf16*)(ws + WS_MIX); bf16* VT_O = (bf16*)(ws + WS_VT_O);
    bf16* ACT = (bf16*)(ws + WS_ACT);
    float* scr = (float*)(lds + wave * 16384);
    volatile LAS unsigned* bst = (volatile LAS unsigned*)((LAS unsigned char*)lds + 131072 + 512);
    if (threadIdx.x < 2) bst[threadIdx.x] = 0u;
    __syncthreads();
    const XcdBarrier bar = xcd_barrier_post((unsigned*)(ws + WS_BAR), bst);
#define GSYNC() xcd_barrier(bar)

#ifndef SKIP_PRO
    for (int prorep = 0; prorep < PRO_REP; ++prorep) {
        FRESH();
        constexpr int I1 = 16 * 29, I2 = 6 * 36, I3 = 4 * 48, I4 = 12 * 32, I5 = 16 * 72, I6a = 16 * 16, I6b = 16 * 4, I7 = 16 * 32, IE = I1 + I2 + I3 + I4 + I5 + I6a + I6b + I7;
        constexpr int IV1 = 8 * 16, IV2 = 8 * 4;
        constexpr int IU = 16 * 176, ID = 44 * 32;
        constexpr int NIT = 2 * IE + 8 * IV1 + 8 * IV2;
        for (int it = gw; it < NIT; it += NGW) {
            int r = it;
            if (r >= 2 * IE + 8 * IV1 + 8 * IV2) {
                continue;
            }
            if (r < 2 * IE) {
                const int e = r / IE; r -= e * IE;
                if (r < I1) { tr_job(r, a.in[12] + (size_t)e * 1024 * 928, 928, 29, 0, WIN_E + (size_t)e * 1024 * 1024, 1024, 0, scr, lane); continue; } r -= I1;
                if (r < I2) { tr_job(r, a.in[15] + (size_t)e * 384 * 1152, 1152, 36, 0, WUQ + (size_t)e * 1280 * 384, 384, 0, scr, lane); continue; } r -= I2;
                if (r < I3) { const int kb = r / 48, nb = r % 48, n0 = 32 * nb, h = n0 >> 7, j0 = n0 & 127;
                    bf16* dst = (j0 >= 64 ? WUV : WUK) + (size_t)e * 768 * 256 + (size_t)(h * 64 + (j0 & 63)) * 256 + 64 * kb;
                    tr_item(a.in[16] + (size_t)e * 256 * 1536 + (size_t)(64 * kb) * 1536 + n0, 1536, dst, 256, scr, lane); continue; } r -= I3;
                if (r < I4) { tr_job(r, a.in[19] + (size_t)e * 1024 * 1024, 1024, 32, 0, WOUT_E + (size_t)e * 1024 * 1024, 1024, 0, scr, lane); continue; } r -= I4;
                if (r < I5) { tr_job(r, a.in[20] + (size_t)e * 1024 * 2304, 2304, 72, 0, WIN_O + (size_t)e * 2304 * 1024, 1024, 0, scr, lane); continue; } r -= I5;
                if (r < I6a) { tr_job(r, a.in[20] + (size_t)e * 1024 * 2304, 2304, 16, 1024, WV_O + (size_t)e * 768 * 1024, 1024, 0, scr, lane); continue; } r -= I6a;
                if (r < I6b) { tr_job(r, a.in[20] + (size_t)e * 1024 * 2304, 2304, 4, 2176, WV_O + (size_t)e * 768 * 1024, 1024, 512, scr, lane); continue; } r -= I6b;
                tr_job(r, a.in[23] + (size_t)e * 1024 * 1024, 1024, 32, 0, WOUT_O + (size_t)e * 1024 * 1024, 1024, 0, scr, lane); continue;
            }
            r -= 2 * IE;
            if (r < 8 * IV1) { const int eb = r / IV1, q = r % IV1, e = eb >> 2, b = eb & 3, kb = q / 16, nb = q % 16;
                tr_item(a.in[3] + ((size_t)(b * 2 + e) * 512 + 64 * kb) * 1024 + 512 + 32 * nb, 1024, VTC_NA + (size_t)e * 512 * 2048 + (size_t)(32 * nb) * 2048 + b * 512 + 64 * kb, 2048, scr, lane); continue; }
            r -= 8 * IV1;
            { const int eb = r / IV2, q = r % IV2, e = eb >> 2, b = eb & 3, kb = q / 4, nb = q % 4;
                tr_item(a.in[4] + ((size_t)(b * 2 + e) * 512 + 64 * kb) * 256 + 128 + 32 * nb, 256, VTC_SW + (size_t)e * 128 * 2048 + (size_t)(32 * nb) * 2048 + b * 512 + 64 * kb, 2048, scr, lane); }
        }
        for (int i = gtid; i < 2 * 96 * 1024 / 8; i += NGT) { const int e = i / (96 * 128), q = i % (96 * 128); *(u32x4*)(WIN_E + (size_t)e * 1024 * 1024 + (size_t)928 * 1024 + 8 * q) = (u32x4){0, 0, 0, 0}; }
        for (int i = gtid; i < 2 * 128 * 384 / 8; i += NGT) { const int e = i / (128 * 48), q = i % (128 * 48); *(u32x4*)(WUQ + (size_t)e * 1280 * 384 + (size_t)1152 * 384 + 8 * q) = (u32x4){0, 0, 0, 0}; }
        for (int i = gtid; i < 2 * 128 * 1024 / 8; i += NGT) { const int e = i / (128 * 128), q = i % (128 * 128); *(u32x4*)(WV_O + (size_t)e * 768 * 1024 + (size_t)640 * 1024 + 8 * q) = (u32x4){0, 0, 0, 0}; }
        for (int i = gtid; i < 2 * 256 * 1024; i += NGT) { const int n = i & 1023, gc = (i >> 10) & 255, e = i >> 18, g = gc >> 6;
            const float* wp = a.in[17] + ((size_t)e * 4 * 64 * 64) + (size_t)gc * 64; const float* psc = a.in[18] + e * 256 + g * 64; const float* wo = a.in[19] + (size_t)e * 1024 * 1024 + (size_t)(768 + g * 64) * 1024 + n;
            float s = 0.f;
            for (int d = 0; d < 64; ++d) s += wp[d] * psc[d] * wo[(size_t)d * 1024];
            WOUT_E[(size_t)e * 1024 * 1024 + (size_t)n * 1024 + 768 + gc] = (bf16)(pk2(s, 0.f) & 0xffffu); }
        for (int i = gtid; i < 2 * 2048 * 512 / 4; i += NGT) { const int c4 = i & 127, row = (i >> 7) & 2047, e = i >> 18, b = row >> 9, t = row & 511;
            const f32x4 v = *(const f32x4*)(a.in[3] + ((size_t)(b * 2 + e) * 512 + t) * 1024 + 4 * c4); u32x2 w; w.x = pk2(v.x, v.y); w.y = pk2(v.z, v.w);
            *(u32x2*)(KC_NA + (size_t)e * 2048 * 512 + (size_t)row * 512 + 4 * c4) = w; }
        for (int i = gtid; i < 2 * 2048 * 128 / 4; i += NGT) { const int c4 = i & 31, row = (i >> 5) & 2047, e = i >> 16, b = row >> 9, t = row & 511;
            const f32x4 v = *(const f32x4*)(a.in[4] + ((size_t)(b * 2 + e) * 512 + t) * 256 + 4 * c4); u32x2 w; w.x = pk2(v.x, v.y); w.y = pk2(v.z, v.w);
            *(u32x2*)(KC_SW + (size_t)e * 2048 * 128 + (size_t)row * 128 + 4 * c4) = w; }
        for (int i = gtid; i < 64 * 8; i += NGT) { const int pos = i >> 3, k = i & 7; const float fr = powf(10000.0f, -(float)k / 8.0f), ang = (float)pos * fr; tab8[2 * i] = cosf(ang); tab8[2 * i + 1] = sinf(ang); }
        for (int i = gtid; i < 64 * 16; i += NGT) { const int pos = i >> 4, k = i & 15; const float fr = powf(10000.0f, -(float)k / 16.0f), ang = (float)pos * fr; tab16[2 * i] = cosf(ang); tab16[2 * i + 1] = sinf(ang); }
        __syncthreads();
        float* sv = (float*)lds;
        for (int it = blockIdx.x; it < 4 * 16 * 12; it += G) {
            const int jg = it % 12, kc = (it / 12) & 15, l = it / 192;
            if (tid < 320) { const int v = tid >> 6, k = tid & 63; const float x = v == 0 ? a.in[6][kc * 64 + k] : a.in[5][(v - 1) * 1024 + kc * 64 + k]; sv[tid] = x / (1.0f + __expf(-x)); }
            __syncthreads();
            const int j = jg * 512 + tid; const float* wm = a.in[7] + (size_t)l * 1024 * 6144 + (size_t)(kc * 64) * 6144 + j;
            float s0 = 0.f, s1 = 0.f, s2 = 0.f, s3 = 0.f, s4 = 0.f;
#pragma unroll 16
            for (int k = 0; k < 64; ++k) { const float w = wm[(size_t)k * 6144]; s0 += sv[k] * w; s1 += sv[64 + k] * w; s2 += sv[128 + k] * w; s3 += sv[192 + k] * w; s4 += sv[256 + k] * w; }
            float* mp = modp + ((size_t)(l * 16 + kc) * 5) * 6144 + j;
            mp[0] = s0; mp[6144] = s1; mp[2 * 6144] = s2; mp[3 * 6144] = s3; mp[4 * 6144] = s4;
            __syncthreads();
        }
    }
#endif
    grid.sync();
    { FRESH();
    for (int i = gtid; i < 4 * 5 * 6144; i += NGT) { const int j = i % 6144, lv = i / 6144, l = lv / 5, v = lv % 5;
        float s = a.in[8][l * 6144 + j];
        for (int kc = 0; kc < 16; ++kc) s += modp[((size_t)(l * 16 + kc) * 5 + v) * 6144 + j];
        mods[i] = s; } }
    GSYNC();

    for (int l = 0; l < 4; ++l) {
        const int e = l >> 1; const float* modsl = mods + (size_t)l * 5 * 6144;
        {
            FRESH();
            {
            if (l == 0) norm_mod_rows(a.in[0], a.in[1], X, HN, a.in[9] + l * 1024, modsl, 0, gw, NGW, lane);
            else norm_mod_rows(X, X + (size_t)NPR * DM, nullptr, HN, a.in[9] + l * 1024, modsl, 0, gw, NGW, lane);
            }
        }
        GSYNC();
        if ((l & 1) == 0) {
            GEMM_BF16(HN, WIN_E + (size_t)e * 1024 * 1024, NTOK, 1024, 1024, Z, 1024);
            GSYNC();
#ifndef SKIP_POST
            { FRESH(); for (int rep_ = 0; rep_ < SIDE_REP; ++rep_) even_post(Z, QAN, LATN, KR, MIX, a.out + OUT_LAT, a.in[2], a.in[13] + e * 384, a.in[14] + e * 256, tab8, e, gw, NGW, lane); pool_rows(Z, MIX, gtid, NGT); }
#endif
            GSYNC();
            GEMM_BF16(QAN, WUQ + (size_t)e * 1280 * 384, NTOK, 1280, 384, QF, 1280);
            GEMM_BF16(LATN, WUK + (size_t)e * 768 * 256, NKV, 768, 256, KNOPE, 768);
            GEMM_BF16(WUV + (size_t)e * 768 * 256, LATN, 768, NKV, 256, VT, NKV);
            GSYNC();
#ifndef SKIP_ATTN
            {
                FRESH();
                const float scale = 0.10206207261596575f;
                for (int rep = 0; rep < ATT_REP; ++rep)
                for (int u = blockIdx.x; u < 768; u += G) {
                    if (u < 384) { const int blk = u & 7, h = (u >> 3) % 12, b = u / 96; const int m0 = NPR + b * 2048 + blk * 256 + wave * 32;
                        attn_block<96, 0, true, true>(QF + (size_t)m0 * 1280 + h * 96, 1280, blk * 256 + wave * 32,
                            KNOPE + h * 64, 768, KR, VT + (size_t)(h * 64) * NKV, NKV, NPR + b * 2048, 32, 0,
                            KNOPE + h * 64, 768, KR, VT + (size_t)(h * 64) * NKV, NKV, NTOK + b * 512, 8,
                            0, 0, 0, scale, false, 0.f, nullptr, tab8, MIX + (size_t)m0 * DM + h * 64, DM, lds, wave, tid);
                    } else { const int v = u - 384, h = v % 12, b = v / 12; const int m0 = b * 256 + wave * 32;
                        attn_block<96, 0, false, true>(QF + (size_t)m0 * 1280 + h * 96, 1280, wave * 32,
                            KNOPE + h * 64, 768, KR, VT + (size_t)(h * 64) * NKV, NKV, b * 256, 4, 0,
                            KNOPE + h * 64, 768, KR, VT + (size_t)(h * 64) * NKV, NKV, 0, 0,
                            0, 0, 0, scale, false, 0.f, nullptr, tab8, MIX + (size_t)m0 * DM + h * 64, DM, lds, wave, tid);
                    }
                }
                if (l == 0 && (int)blockIdx.x >= G / 2) {
                    constexpr int IU = 16 * 176, ID = 44 * 32;
                    const int cw_ = ((int)blockIdx.x - G / 2) * 8 + wave, ncw_ = (G - G / 2) * 8;
                    for (int it = cw_; it < 4 * (IU + ID); it += ncw_) {
                        const int ll = it / (IU + ID); const int r = it - ll * (IU + ID);
                        if (r < IU) { const int kb = r / 176, nb = r % 176, n0 = 32 * nb, f = n0 < DFF ? n0 : n0 - DFF, row = (f >> 7) * 256 + (n0 >= DFF ? 128 : 0) + (f & 127);
                            tr_item(a.in[24] + (size_t)ll * 1024 * 5632 + (size_t)(64 * kb) * 5632 + n0, 5632, WUP + (size_t)ll * 5632 * 1024 + (size_t)row * 1024 + 64 * kb, 1024, scr, lane); }
                        else tr_job(r - IU, a.in[27] + (size_t)ll * DFF * 1024, 1024, 32, 0, WDOWN + (size_t)ll * 1024 * DFF, DFF, 0, scr, lane);
                    }
                }
            }
#endif
            GSYNC();
            GEMM_RES(MIX, WOUT_E + (size_t)e * 1024 * 1024, 1024, modsl + 2 * 1024);
        } else {
            { const bf16* win = WIN_O + (size_t)e * 2304 * 1024; const bf16* wv = WV_O + (size_t)e * 768 * 1024;
              pg8::Gemm g_{(const pg8::bf16_t*)HN, (const pg8::bf16_t*)win, NTOK, 2304, 1024};
              OddOrder S_; S_.init(G, (int)blockIdx.x, (size_t)((const char*)wv - (const char*)HN), (size_t)((const char*)HN - (const char*)win));
              EpiOdd E_{pg8::EpiBf16<0>{(pg8::bf16_t*)Z, 2304, nullptr, 0, 0, 1.f}, pg8::EpiBf16<0>{(pg8::bf16_t*)VT_O, NTOK, nullptr, 0, 0, 1.f}};
              pg8::gemm_phase<EpiOdd, OddOrder, true, true>(ldsg, g_, S_, E_); }
            GSYNC();
#ifndef SKIP_POST
            { FRESH(); odd_post(Z, a.out + OUT_NA, a.out + OUT_SW, tab16, e, gw, NGW, lane); }
#endif
            GSYNC();
#ifndef SKIP_ATTN
            {
                FRESH();
                const float scale = 0.125f;
                const bf16* kcna = KC_NA + (size_t)e * 2048 * 512; const bf16* vtcna = VTC_NA + (size_t)e * 512 * 2048;
                const bf16* kcsw = KC_SW + (size_t)e * 2048 * 128; const bf16* vtcsw = VTC_SW + (size_t)e * 128 * 2048;
                for (int rep = 0; rep < ATT_REP; ++rep)
                for (int u = blockIdx.x; u < 1024; u += G) {
                    const int kind = u >> 8, v = u & 255;
                    if (kind == 0) {
                        const int blk = v & 7, h = (v >> 3) & 7, b = v >> 6; const int gr0 = 4 * blk, gr = gr0 + (wave >> 1), qp0 = gr * 64 + (wave & 1) * 32, m0 = NPR + b * 2048 + qp0;
                        int rlo = gr0 - 4; rlo = rlo < 0 ? 0 : (rlo > 24 ? 24 : rlo);
                        int rhi = gr0 - 1; rhi = (rhi < 0 ? 0 : (rhi > 24 ? 24 : rhi)) + 7;
                        int r0 = gr - 4; r0 = r0 < 0 ? 0 : (r0 > 24 ? 24 : r0);
                        attn_block<64, 1, false, false>(Z + (size_t)m0 * 2304 + h * 64, 2304, qp0,
                            Z + 512 + h * 64, 2304, nullptr, VT_O + (size_t)(h * 64) * NTOK, NTOK, NPR + b * 2048 + rlo * 64, rhi - rlo + 1, rlo * 64,
                            kcna + h * 64, 512, nullptr, vtcna + (size_t)(h * 64) * 2048, 2048, b * 512, 8,
                            r0 - rlo, r0 - rlo + 7, r0, scale, false, 0.f, a.in[21] + ((size_t)e * 8 + h) * 15 * 31, tab16, MIX + (size_t)m0 * DM + h * 64, DM, lds, wave, tid);
                    } else if (kind == 1) {
                        const int blk = v & 7, hq = (v >> 3) & 7, b = v >> 6, hk = hq >> 2; const int qt = 8 * blk + wave, qp0 = qt * 32, m0 = NPR + b * 2048 + qp0;
                        const int tlo = 4 * blk - 2 < 0 ? 0 : 4 * blk - 2, thi = 4 * blk + 5 > 31 ? 31 : 4 * blk + 5;
                        const int wlo = (qt - 4 < 0 ? 0 : qt - 4) >> 1, whi = (qt + 4 > 63 ? 63 : qt + 4) >> 1;
                        attn_block<64, 2, true, false>(Z + (size_t)m0 * 2304 + 1536 + hq * 64, 2304, qp0,
                            Z + 2048 + hk * 64, 2304, nullptr, VT_O + (size_t)(512 + hk * 64) * NTOK, NTOK, NPR + b * 2048 + tlo * 64, thi - tlo + 1, tlo * 64,
                            kcsw + hk * 64, 128, nullptr, vtcsw + (size_t)(hk * 64) * 2048, 2048, b * 512, 8,
                            wlo - tlo, whi - tlo, 0, scale, true, a.in[22][e * 8 + hq], nullptr, tab16, MIX + (size_t)m0 * DM + 512 + hq * 64, DM, lds, wave, tid);
                    } else if (kind == 2) {
                        const int h = v & 7, b = v >> 3; const int m0 = b * 256 + wave * 32;
                        attn_block<64, 0, false, false>(Z + (size_t)m0 * 2304 + h * 64, 2304, wave * 32,
                            Z + 512 + h * 64, 2304, nullptr, VT_O + (size_t)(h * 64) * NTOK, NTOK, b * 256, 4, 0,
                            Z + 512 + h * 64, 2304, nullptr, VT_O + (size_t)(h * 64) * NTOK, NTOK, 0, 0,
                            0, 0, 0, scale, false, 0.f, nullptr, tab16, MIX + (size_t)m0 * DM + h * 64, DM, lds, wave, tid);
                    } else {
                        const int hq = v & 7, b = v >> 3, hk = hq >> 2; const int m0 = b * 256 + wave * 32;
                        attn_block<64, 0, false, false>(Z + (size_t)m0 * 2304 + 1536 + hq * 64, 2304, wave * 32,
                            Z + 2048 + hk * 64, 2304, nullptr, VT_O + (size_t)(512 + hk * 64) * NTOK, NTOK, b * 256, 4, 0,
                            Z + 2048 + hk * 64, 2304, nullptr, VT_O + (size_t)(512 + hk * 64) * NTOK, NTOK, 0, 0,
                            0, 0, 0, scale, true, a.in[22][e * 8 + hq], nullptr, tab16, MIX + (size_t)m0 * DM + 512 + hq * 64, DM, lds, wave, tid);
                    }
                }
            }
#endif
            GSYNC();
            GEMM_RES(MIX, WOUT_O + (size_t)e * 1024 * 1024, 1024, modsl + 2 * 1024);
        }
        GSYNC();
        { FRESH(); for (int rep_ = 0; rep_ < SIDE_REP; ++rep_) norm_mod_rows(X, X + (size_t)NPR * DM, nullptr, HN, a.in[10] + l * 1024, modsl, 3, gw, NGW, lane); }
        GSYNC();
        { pg8::Gemm g_{(const pg8::bf16_t*)HN, (const pg8::bf16_t*)(WUP + (size_t)l * 5632 * 1024), 68 * 256, 5632, 1024}; UpOrder S_; S_.init(68 * 256, 5632, G, (int)blockIdx.x);
          EpiUpConv E_{ACT, a.in[25] + (size_t)l * 3 * 5632, a.in[26] + (size_t)l * 5632, (float*)(lds + 131072 + 1024)};
          pg8::gemm_phase<EpiUpConv, UpOrder, true, true>(ldsg, g_, S_, E_); }
        GSYNC();
        GEMM_RES(ACT, WDOWN + (size_t)l * 1024 * DFF, DFF, modsl + 5 * 1024);
        GSYNC();
    }
    { FRESH(); int gwf = gw; asm volatile("" : "+s"(gwf)); final_norm_rows(X, a.out + OUT_Y, a.in[11], gwf, NGW, lane); }
}

extern "C" void kernel_launch(void* const* d_in, const int* in_sizes, int n_in, void* d_out, int out_size, void* d_ws, size_t ws_size, hipStream_t stream) {
    static int grid = 0;
    if (grid == 0) {
        if (n_in != 28 || ws_size < WS_END) { fprintf(stderr, "kernel_launch: unexpected n_in %d / ws_size %zu (need %zu)\n", n_in, ws_size, (size_t)WS_END); grid = -1; return; }
        int dev = 0, cus = 0, per_cu = 0;
        (void)hipGetDevice(&dev); (void)hipDeviceGetAttribute(&cus, hipDeviceAttributeMultiprocessorCount, dev);
        if (hipFuncSetAttribute((const void*)fwd_kernel, hipFuncAttributeMaxDynamicSharedMemorySize, LDS_BYTES) != hipSuccess) { fprintf(stderr, "kernel_launch: hipFuncSetAttribute failed\n"); grid = -1; return; }
        if (hipOccupancyMaxActiveBlocksPerMultiprocessor(&per_cu, (const void*)fwd_kernel, 512, LDS_BYTES) != hipSuccess || per_cu < 1) { fprintf(stderr, "kernel_launch: occupancy query says %d\n", per_cu); per_cu = 1; }
        (void)hipGetLastError();
        grid = cus * 1;
        if (grid <= 0) grid = 256;
    }
    if (grid < 0) return;
    if (hipMemsetAsync((unsigned char*)d_ws + WS_BAR, 0, 16384, stream) != hipSuccess) { fprintf(stderr, "kernel_launch: memset failed\n"); return; }
    Args a{};
    for (int i = 0; i < 28; ++i) a.in[i] = (const float*)d_in[i];
    a.out = (float*)d_out; a.ws = (unsigned char*)d_ws;
    void* args[] = {&a};
    hipError_t e = hipLaunchCooperativeKernel((const void*)fwd_kernel, dim3(grid), dim3(512), args, LDS_BYTES, stream);
    if (e != hipSuccess) fprintf(stderr, "cooperative launch failed: %s (grid %d)\n", hipGetErrorString(e), grid);
}
```
